# Optimizing an MI355X kernel written in HIP

```python
import jax, jax.numpy as jnp
from jax import lax
import numpy as np

D_MODEL = 1024
BATCH = 32
SEQ = 2048
DEPTH = 4

GRID_W = 64
HEAD_DIM = 64
N_HEADS_A = D_MODEL // (2 * HEAD_DIM)
N_HEADS_B = D_MODEL // (4 * HEAD_DIM)
N_GROUPS_C = D_MODEL // (4 * HEAD_DIM)
WIDTH_A = N_HEADS_A * HEAD_DIM
WIDTH_B = N_HEADS_B * HEAD_DIM
WIDTH_C = N_GROUPS_C * HEAD_DIM
MIX_WIDTH = WIDTH_A + WIDTH_B + WIDTH_C
N_HEADS_TOTAL = MIX_WIDTH // HEAD_DIM
IN_WIDTH = 3 * WIDTH_A + 2 * WIDTH_B + WIDTH_C
NA_ROWS_MAX = 8
NA_COLS = 16
CHUNK = 128
D_FF = -(-8 * D_MODEL // (3 * 256)) * 256
EPS = 1e-6
NEG_INF = -1e9

kernel_name = "hybrid_natten_gmlp_fnet_encoder"


def rms_norm(x, g):
    xf = x.astype(jnp.float32)
    y = xf * lax.rsqrt(jnp.mean(xf * xf, axis=-1, keepdims=True) + EPS)
    return (y * g.astype(jnp.float32)).astype(x.dtype)


def layer_norm(x, g, b):
    xf = x.astype(jnp.float32)
    mu = jnp.mean(xf, axis=-1, keepdims=True)
    var = jnp.mean(jnp.square(xf - mu), axis=-1, keepdims=True)
    y = (xf - mu) * lax.rsqrt(var + EPS)
    return (y * g.astype(jnp.float32) + b.astype(jnp.float32)).astype(x.dtype)


def head_rms_norm(y, g):
    b_, s, _ = y.shape
    yf = y.astype(jnp.float32).reshape(b_, s, N_HEADS_TOTAL, HEAD_DIM)
    yf = yf * lax.rsqrt(jnp.mean(yf * yf, axis=-1, keepdims=True) + EPS)
    return (yf.reshape(b_, s, MIX_WIDTH) * g.astype(jnp.float32)).astype(y.dtype)


def neighbourhood_attention(q, k, v, rpb):
    b_, s, h, dh = q.shape
    rows = s // GRID_W
    kh = min(NA_ROWS_MAX, rows)
    kw = NA_COLS
    band = 2 * kw
    nqb = GRID_W // kw
    scale = HEAD_DIM ** -0.5

    qg = q.reshape(b_, rows, nqb, kw, h, dh)
    kg = k.reshape(b_, rows, GRID_W, h, dh)
    vg = v.reshape(b_, rows, GRID_W, h, dh)

    qcol = np.arange(GRID_W).reshape(nqb, kw)
    band_start = np.clip(np.arange(nqb) * kw - kw // 2, 0, GRID_W - band)
    band_cols = band_start[:, None] + np.arange(band)[None, :]
    win_start = np.clip(qcol - kw // 2, 0, GRID_W - kw)
    kc = band_cols[:, None, :]
    in_win = (kc >= win_start[..., None]) & (kc < win_start[..., None] + kw)
    dcol_idx = np.clip(kc - qcol[..., None] + NA_COLS - 1, 0, 2 * NA_COLS - 2)
    col_bias = rpb.astype(jnp.float32)[:, :, dcol_idx]
    col_bias = jnp.where(jnp.asarray(in_win)[None, None], col_bias, NEG_INF)

    def row_step(r):
        rs = jnp.clip(r - kh // 2, 0, rows - kh)
        k_slab = lax.dynamic_slice_in_dim(kg, rs, kh, axis=1)
        v_slab = lax.dynamic_slice_in_dim(vg, rs, kh, axis=1)
        k_band = k_slab[:, :, band_cols]
        v_band = v_slab[:, :, band_cols]
        q_row = lax.dynamic_index_in_dim(qg, r, axis=1, keepdims=False)
        sc = jnp.einsum('bjqhd,bkjnhd->bhjqkn', q_row, k_band).astype(jnp.float32) * scale
        drow_idx = rs + jnp.arange(kh) - r + NA_ROWS_MAX - 1
        bias = col_bias[:, drow_idx].transpose(0, 2, 3, 1, 4)
        logits = (sc + bias[None]).reshape(b_, h, nqb, kw, kh * band)
        p = jax.nn.softmax(logits, axis=-1).reshape(b_, h, nqb, kw, kh, band).astype(v.dtype)
        o = jnp.einsum('bhjqkn,bkjnhd->bjqhd', p, v_band)
        return o.reshape(b_, GRID_W, h, dh)

    out = lax.map(row_step, jnp.arange(rows))
    return out.transpose(1, 0, 2, 3, 4).reshape(b_, s, h * dh)


def spatial_gating(z, ln_g, ln_b, w_s, b_s):
    b_, s, _ = z.shape
    z = jax.nn.gelu(z)
    u, v = jnp.split(z, 2, axis=-1)
    v = layer_norm(v, ln_g, ln_b)
    vc = v.reshape(b_, s // CHUNK, CHUNK, N_HEADS_B, HEAD_DIM)
    mixed = jnp.einsum('hpq,bnqhd->bnphd', w_s, vc) + b_s.T[None, None, :, :, None]
    return u * mixed.reshape(b_, s, WIDTH_B)


def fourier_mix(xc):
    b_, s, _ = xc.shape
    xf = xc.astype(jnp.float32).reshape(b_, s, N_GROUPS_C, HEAD_DIM)
    y = jnp.real(jnp.fft.fft2(xf, axes=(1, 3), norm="ortho"))
    return y.astype(xc.dtype).reshape(b_, s, WIDTH_C)


def setup_inputs(seed: int = 0) -> dict:
    key = jax.random.key(seed)
    ks = jax.random.split(key, 16)
    f32 = jnp.float32
    nrm = lambda k, shp, sc: jax.random.normal(k, shp, f32) * sc
    return {
        "x": jax.random.normal(ks[0], (BATCH, SEQ, D_MODEL), f32),
        "norm_mix_g": 1.0 + nrm(ks[1], (DEPTH, D_MODEL), 0.05),
        "w_in": nrm(ks[2], (DEPTH, D_MODEL, IN_WIDTH), D_MODEL ** -0.5),
        "rpb": nrm(ks[3], (DEPTH, N_HEADS_A, 2 * NA_ROWS_MAX - 1, 2 * NA_COLS - 1), 0.5),
        "gmlp_ln_g": 1.0 + nrm(ks[4], (DEPTH, WIDTH_B), 0.05),
        "gmlp_ln_b": nrm(ks[5], (DEPTH, WIDTH_B), 0.02),
        "w_spatial": nrm(ks[6], (DEPTH, N_HEADS_B, CHUNK, CHUNK), CHUNK ** -0.5),
        "b_spatial": 1.0 + nrm(ks[7], (DEPTH, N_HEADS_B, CHUNK), 0.1),
        "head_norm_g": 1.0 + nrm(ks[8], (DEPTH, MIX_WIDTH), 0.05),
        "w_out": nrm(ks[9], (DEPTH, MIX_WIDTH, D_MODEL), MIX_WIDTH ** -0.5),
        "norm_ffn_g": 1.0 + nrm(ks[10], (DEPTH, D_MODEL), 0.05),
        "w_gate": nrm(ks[11], (DEPTH, D_MODEL, D_FF), D_MODEL ** -0.5),
        "w_up": nrm(ks[12], (DEPTH, D_MODEL, D_FF), D_MODEL ** -0.5),
        "w_down": nrm(ks[13], (DEPTH, D_FF, D_MODEL), D_FF ** -0.5),
        "final_norm_g": 1.0 + nrm(ks[14], (D_MODEL,), 0.05),
    }


def reference(x, norm_mix_g, w_in, rpb, gmlp_ln_g, gmlp_ln_b, w_spatial, b_spatial,
              head_norm_g, w_out, norm_ffn_g, w_gate, w_up, w_down, final_norm_g):
    b_, s, _ = x.shape
    splits = [WIDTH_A, 2 * WIDTH_A, 3 * WIDTH_A, 3 * WIDTH_A + 2 * WIDTH_B]
    for l in range(DEPTH):
        h = rms_norm(x, norm_mix_g[l])
        proj = h @ w_in[l]
        q, k, v, z_b, x_c = jnp.split(proj, splits, axis=-1)
        mix_a = neighbourhood_attention(q.reshape(b_, s, N_HEADS_A, HEAD_DIM),
                                        k.reshape(b_, s, N_HEADS_A, HEAD_DIM),
                                        v.reshape(b_, s, N_HEADS_A, HEAD_DIM), rpb[l])
        mix_b = spatial_gating(z_b, gmlp_ln_g[l], gmlp_ln_b[l], w_spatial[l], b_spatial[l])
        mix_c = fourier_mix(x_c)
        mix = head_rms_norm(jnp.concatenate([mix_a, mix_b, mix_c], axis=-1), head_norm_g[l])
        x = x + mix @ w_out[l]
        h = rms_norm(x, norm_ffn_g[l])
        x = x + (jax.nn.silu(h @ w_gate[l]) * (h @ w_up[l])) @ w_down[l]
    return rms_norm(x, final_norm_g)
```

```cpp
#include <hip/hip_runtime.h>
#include <hip/hip_cooperative_groups.h>
#include <cstdio>
#include <cstdint>
namespace cg = cooperative_groups;

#define LAS __attribute__((address_space(3)))
typedef unsigned short bf16_t;
typedef short bf16x8 __attribute__((ext_vector_type(8)));
typedef float f32x4 __attribute__((ext_vector_type(4)));
typedef unsigned u32x4 __attribute__((ext_vector_type(4)));
typedef unsigned u32x2 __attribute__((ext_vector_type(2)));

constexpr int DM = 1024, NBATCH = 32, SEQ = 2048, DEPTH = 4, MTOK = NBATCH * SEQ;
constexpr int INW = 2304, DFF = 2816, NGU = 2 * DFF;
constexpr int C_Q = 0, C_K = 512, C_V = 1024, C_U = 1536, C_VG = 1792, C_XC = 2048;
constexpr float EPS = 1e-6f;
constexpr int LDS_BYTES = 155648;

constexpr size_t MiB = 1u << 20;
constexpr size_t SZ_WIN = (size_t)INW * DM * 2, SZ_WOUT = (size_t)DM * DM * 2, SZ_WGU = (size_t)NGU * DM * 2, SZ_WDN = (size_t)DM * DFF * 2;
constexpr size_t WS_WIN = 0;
constexpr size_t WS_WOUT = 18 * MiB;
constexpr size_t WS_WGU = 26 * MiB;
constexpr size_t WS_WDN = 70 * MiB;
constexpr size_t WS_WSP = 92 * MiB;
constexpr size_t WS_T = 93 * MiB;
constexpr size_t WS_SSQ = 109 * MiB;
constexpr size_t WS_XB = 113 * MiB;
constexpr size_t WS_ABT = 241 * MiB;
constexpr size_t WS_PROJ = 305 * MiB;
constexpr size_t WS_MIX = 593 * MiB;
constexpr size_t WS_HID = WS_PROJ;
constexpr size_t WS_CTL = 721 * MiB;
constexpr size_t WS_END = 722 * MiB;
static_assert(4 * SZ_WIN <= 18 * MiB && 4 * SZ_WGU <= 44 * MiB && 4 * SZ_WDN <= 22 * MiB && (size_t)MTOK * DFF * 2 <= 416 * MiB, "ws map");

typedef __bf16 bf16v2 __attribute__((ext_vector_type(2)));
typedef float f32v2 __attribute__((ext_vector_type(2)));
__device__ __forceinline__ unsigned cvt_pk_bf16(float lo, float hi) { const f32v2 v = {lo, hi}; const bf16v2 b = __builtin_convertvector(v, bf16v2); return __builtin_bit_cast(unsigned, b); }
__device__ __forceinline__ float bf2f(unsigned h) { return __uint_as_float(h << 16); }
__device__ __forceinline__ float gelu_tanh(float x) { const float t = -2.3022082f * (x + 0.044715f * x * x * x); return x * __builtin_amdgcn_rcpf(1.0f + __builtin_amdgcn_exp2f(t)); }
__device__ __forceinline__ float silu_f(float x) { return x * __builtin_amdgcn_rcpf(1.0f + __builtin_amdgcn_exp2f(-1.44269504f * x)); }
__device__ __forceinline__ float wave_sum(float v) {
#pragma unroll
    for (int o = 1; o < 64; o <<= 1) v += __shfl_xor(v, o);
    return v;
}
typedef unsigned long long u64;
constexpr float RSS_SCALE = 16777216.0f;
__device__ __forceinline__ float row_rs(const u64* rss, int row) { return rsqrtf((float)rss[row] * (1.0f / (RSS_SCALE * 1024.0f)) + EPS); }
__device__ __forceinline__ void headnorm_store(f32x4 (&o)[4], bf16_t* dst) {
    float ss = 0.f;
#pragma unroll
    for (int dg = 0; dg < 4; ++dg) ss += (o[dg][0] * o[dg][0] + o[dg][1] * o[dg][1]) + (o[dg][2] * o[dg][2] + o[dg][3] * o[dg][3]);
    ss += __shfl_xor(ss, 16); ss += __shfl_xor(ss, 32);
    const float sc = rsqrtf(ss * (1.0f / 64.0f) + EPS);
#pragma unroll
    for (int dg = 0; dg < 4; ++dg) { u32x2 w; w.x = cvt_pk_bf16(o[dg][0] * sc, o[dg][1] * sc); w.y = cvt_pk_bf16(o[dg][2] * sc, o[dg][3] * sc); *(u32x2*)(dst + 16 * dg) = w; }
}

namespace pg8 {
constexpr int BM = 256, BK = 64, HALF = 128, HTB = HALF * BK * 2, STAGE_BYTES = 8 * HTB, NXCD = 8, WGM = 8;
__host__ __device__ __forceinline__ int lds_byte(int r, int c) { const int st = (r >> 4) * 2 + (c >> 5), rr = r & 15, cc = c & 31, ob = rr * 64 + cc * 2; return st * 1024 + (ob ^ (((ob >> 9) & 1) << 5)); }
__host__ __device__ __forceinline__ void stage_rc(int b, int& R, int& C) { const int st = b / 1024, sb = b % 1024, swz = sb ^ (((sb >> 9) & 1) << 5); R = (st >> 1) * 16 + swz / 64; C = (st & 1) * 32 + (swz % 64) / 2; }
__host__ __device__ __forceinline__ int perm32(int rho) { const int n = rho >> 4, i = rho & 15; return 8 * (i >> 2) + 4 * n + (i & 3); }

struct Unit { int pm, pn; };
struct Gemm { const bf16_t* A; const bf16_t* Bt; int M, N, K; };

struct StaticOrder {
    int nM, nN, nwg, G, c;
    __device__ void init(int M, int N, int G_, int c_) { nM = M / BM; nN = N / BM; nwg = nM * nN; G = G_; c = c_; }
    __device__ bool next(int i, Unit& u) const {
        const long L = (long)i * G + c; if (L >= nwg) return false;
        int wgid = (int)L; { const int q = nwg / NXCD, r = nwg % NXCD, xcd = wgid % NXCD, off = wgid / NXCD; wgid = (xcd < r ? xcd * (q + 1) : r * (q + 1) + (xcd - r) * q) + off; }
        const int nig = WGM * nN, gid = wgid / nig, fm = gid * WGM, gsz = (nM - fm) < WGM ? (nM - fm) : WGM;
        u.pm = fm + ((wgid % nig) % gsz); u.pn = (wgid % nig) / gsz; return true;
    }
    __device__ __forceinline__ void a_ready(const Unit&) const {}
    __device__ __forceinline__ void done(const Unit&) const {}
};
struct DftOrder {
    int G, c;
    __device__ void init(int G_, int c_) { G = G_; c = c_; }
    __device__ bool next(int i, Unit& u) const {
        const long L = (long)i * G + c; if (L >= 256) return false;
        const int x = (int)L & 7, j = (int)L >> 3; u.pm = j & 7; u.pn = x * 4 + (j >> 3); return true;
    }
    __device__ __forceinline__ void a_ready(const Unit&) const {}
    __device__ __forceinline__ void done(const Unit&) const {}
};

struct EpiProj {
    static constexpr bool PERM = true, AFTER_DRAIN = false;
    bf16_t* O; int ldc; const u64* ssq;
    __device__ __forceinline__ void operator()(const f32x4 (&acc)[2][2][4][2], const Unit& u, int wr, int wc, int fr, int fq) const {
        const int row0 = u.pm * BM + wr * 64 + fr, col0 = u.pn * BM + wc * 32 + 8 * fq;
        float rsv[2][4];
#pragma unroll
        for (int ai = 0; ai < 2; ++ai)
#pragma unroll
            for (int m = 0; m < 4; ++m) rsv[ai][m] = row_rs(ssq, row0 + ai * HALF + m * 16);
#pragma unroll
        for (int ai = 0; ai < 2; ++ai)
#pragma unroll
            for (int m = 0; m < 4; ++m) { const int row = row0 + ai * HALF + m * 16; const float rs = rsv[ai][m]; bf16_t* rowp = O + (size_t)row * ldc + col0;
#pragma unroll
                for (int bj = 0; bj < 2; ++bj) { const f32x4 v0 = acc[ai][bj][m][0] * rs, v1 = acc[ai][bj][m][1] * rs;
                    u32x4 w; w.x = cvt_pk_bf16(v0[0], v0[1]); w.y = cvt_pk_bf16(v0[2], v0[3]); w.z = cvt_pk_bf16(v1[0], v1[1]); w.w = cvt_pk_bf16(v1[2], v1[3]);
                    *(u32x4*)(rowp + bj * HALF) = w; } }
    }
};
struct EpiGU {
    static constexpr bool PERM = true, AFTER_DRAIN = false;
    bf16_t* O; const u64* ssq;
    __device__ __forceinline__ void operator()(const f32x4 (&acc)[2][2][4][2], const Unit& u, int wr, int wc, int fr, int fq) const {
        const int row0 = u.pm * BM + wr * 64 + fr, col0 = u.pn * HALF + wc * 32 + 8 * fq;
        float rsv[2][4];
#pragma unroll
        for (int ai = 0; ai < 2; ++ai)
#pragma unroll
            for (int m = 0; m < 4; ++m) rsv[ai][m] = row_rs(ssq, row0 + ai * HALF + m * 16);
#pragma unroll
        for (int ai = 0; ai < 2; ++ai)
#pragma unroll
            for (int m = 0; m < 4; ++m) { const int row = row0 + ai * HALF + m * 16; const float rs = rsv[ai][m];
                f32x4 h[2];
#pragma unroll
                for (int n = 0; n < 2; ++n) { const f32x4 g = acc[ai][0][m][n] * rs, up = acc[ai][1][m][n] * rs;
#pragma unroll
                    for (int e = 0; e < 4; ++e) h[n][e] = silu_f(g[e]) * up[e]; }
                u32x4 w; w.x = cvt_pk_bf16(h[0][0], h[0][1]); w.y = cvt_pk_bf16(h[0][2], h[0][3]); w.z = cvt_pk_bf16(h[1][0], h[1][1]); w.w = cvt_pk_bf16(h[1][2], h[1][3]);
                *(u32x4*)(O + (size_t)row * DFF + col0) = w; }
    }
};
struct EpiRes {
    static constexpr bool PERM = true, AFTER_DRAIN = false;
    bf16_t* xb; u64* ssq;
    __device__ __forceinline__ void operator()(const f32x4 (&acc)[2][2][4][2], const Unit& u, int wr, int wc, int fr, int fq) const {
        const int row0 = u.pm * BM + wr * 64 + fr, col0 = u.pn * BM + wc * 32 + 8 * fq;
        u32x4 bb[2][2];
#define RES_LOAD(idx) do { const size_t off_ = (size_t)(row0 + ((idx) >> 2) * HALF + ((idx) & 3) * 16) * DM + col0; \
            bb[(idx) & 1][0] = *(const u32x4*)(xb + off_); bb[(idx) & 1][1] = *(const u32x4*)(xb + off_ + HALF); } while (0)
        RES_LOAD(0);
        asm volatile("" ::: "memory");
#pragma unroll
        for (int idx = 0; idx < 8; ++idx) { const int ai = idx >> 2, m = idx & 3; const int row = row0 + ai * HALF + m * 16; const size_t off = (size_t)row * DM + col0; float ss = 0.f;
            if (idx < 7) RES_LOAD(idx + 1);
#pragma unroll
            for (int bj = 0; bj < 2; ++bj) { const u32x4 b = bb[idx & 1][bj];
                const f32x4 r0 = (f32x4){bf2f(b.x & 0xffffu), bf2f(b.x >> 16), bf2f(b.y & 0xffffu), bf2f(b.y >> 16)}, r1 = (f32x4){bf2f(b.z & 0xffffu), bf2f(b.z >> 16), bf2f(b.w & 0xffffu), bf2f(b.w >> 16)};
                const f32x4 v0 = r0 + acc[ai][bj][m][0], v1 = r1 + acc[ai][bj][m][1];
                u32x4 w; w.x = cvt_pk_bf16(v0[0], v0[1]); w.y = cvt_pk_bf16(v0[2], v0[3]); w.z = cvt_pk_bf16(v1[0], v1[1]); w.w = cvt_pk_bf16(v1[2], v1[3]);
                *(u32x4*)(xb + off + bj * HALF) = w;
                ss += (v0[0] * v0[0] + v0[1] * v0[1]) + (v0[2] * v0[2] + v0[3] * v0[3]) + (v1[0] * v1[0] + v1[1] * v1[1]) + (v1[2] * v1[2] + v1[3] * v1[3]); }
            ss += __shfl_xor(ss, 16); ss += __shfl_xor(ss, 32);
            if (fq == 0) (void)__hip_atomic_fetch_add(ssq + row, (u64)(ss * RSS_SCALE), __ATOMIC_RELAXED, __HIP_MEMORY_SCOPE_AGENT);
            asm volatile("" ::: "memory"); }
#undef RES_LOAD
    }
};
struct EpiDft {
    static constexpr bool PERM = true, AFTER_DRAIN = false;
    bf16_t* mix;
    __device__ __forceinline__ void operator()(const f32x4 (&acc)[2][2][4][2], const Unit& u, int wr, int wc, int fr, int fq) const {
        const int row0 = u.pn * SEQ + u.pm * BM + wr * 64 + fr;
#pragma unroll
        for (int ai = 0; ai < 2; ++ai)
#pragma unroll
            for (int m = 0; m < 4; ++m) { const int row = row0 + ai * HALF + m * 16; float ss = 0.f;
#pragma unroll
                for (int bj = 0; bj < 2; ++bj)
#pragma unroll
                    for (int n = 0; n < 2; ++n) { const f32x4 v = acc[ai][bj][m][n]; ss += (v[0] * v[0] + v[1] * v[1]) + (v[2] * v[2] + v[3] * v[3]); }
                ss += __shfl_xor(ss, 16); ss += __shfl_xor(ss, 32);
                const float sc = rsqrtf(ss * (1.0f / 64.0f) + EPS);
                bf16_t* rowp = mix + (size_t)row * DM + 768 + 64 * wc + 8 * fq;
#pragma unroll
                for (int bj = 0; bj < 2; ++bj) { const f32x4 v0 = acc[ai][bj][m][0] * sc, v1 = acc[ai][bj][m][1] * sc;
                    u32x4 w; w.x = cvt_pk_bf16(v0[0], v0[1]); w.y = cvt_pk_bf16(v0[2], v0[3]); w.z = cvt_pk_bf16(v1[0], v1[1]); w.w = cvt_pk_bf16(v1[2], v1[3]);
                    *(u32x4*)(rowp + 32 * bj) = w; }
                asm volatile("" ::: "memory"); }
    }
};

template <class Epi, class Sched, bool ALIGN_EPI = false, bool SP2 = false>
__device__ __forceinline__ void gemm_phase(LAS unsigned char* lds, const Gemm g, const Sched& S, const Epi& E) {
    int tid_ = threadIdx.x; asm volatile("" : "+v"(tid_));
    const int tid = tid_, wid = __builtin_amdgcn_readfirstlane(tid >> 6), lane = tid & 63, wr = wid >> 2, wc = wid & 3, fr = lane & 15, fq = lane >> 4;
    const int K = g.K, nt = K / BK;
    unsigned voffA[2], voffB[2];
#pragma unroll
    for (int i = 0; i < 2; ++i) { int R, C; stage_rc(tid * 16 + i * 8192, R, C); const int Rb = Epi::PERM ? ((R & ~31) + perm32(R & 31)) : R;
        voffA[i] = (unsigned)(R * K + C) * 2u; voffB[i] = (unsigned)(Rb * K + C) * 2u; }
    const size_t kstep = (size_t)(BK * 2);
    const size_t hstep = (size_t)HALF * K * 2;
    const size_t tstep = 2 * hstep;
    const unsigned ldsw = (unsigned)wid * 1024u;
    const int aoff = lds_byte(wr * 64 + fr, fq * 8), boff = lds_byte(wc * 32 + fr, fq * 8);
#define PG8_SA(b, h) (((b) * 2 + (h)) * HTB)
#define PG8_SB(b, h) ((4 + (b) * 2 + (h)) * HTB)
#define PG8_STAGE(bufoff, gbase, voff) do { _Pragma("unroll") for (int _i = 0; _i < 2; ++_i) \
        __builtin_amdgcn_global_load_lds((const unsigned*)((const char*)(gbase) + (voff)[_i]), (LAS unsigned*)(lds + (bufoff) + ldsw + _i * 8192), 16, 0, 0); } while (0)
#define PG8_LDA(dst, b, h) do { _Pragma("unroll") for (int m = 0; m < 4; ++m) _Pragma("unroll") for (int k = 0; k < 2; ++k) dst[m][k] = *(const LAS bf16x8*)(lds + PG8_SA(b, h) + aoff + m * 2048 + k * 1024); } while (0)
#define PG8_LDB(dst, b, h) do { _Pragma("unroll") for (int n = 0; n < 2; ++n) _Pragma("unroll") for (int k = 0; k < 2; ++k) dst[n][k] = *(const LAS bf16x8*)(lds + PG8_SB(b, h) + boff + n * 2048 + k * 1024); } while (0)
#define PG8_MMA(ai, bj, At, Bt) do { __builtin_amdgcn_s_setprio(1); _Pragma("unroll") for (int m = 0; m < 4; ++m) _Pragma("unroll") for (int n = 0; n < 2; ++n) _Pragma("unroll") for (int k = 0; k < 2; ++k) \
        acc[ai][bj][m][n] = __builtin_amdgcn_mfma_f32_16x16x32_bf16(Bt[n][k], At[m][k], acc[ai][bj][m][n], 0, 0, 0); __builtin_amdgcn_s_setprio(0); } while (0)
#define PG8_WAIT_V(n) asm volatile("s_waitcnt vmcnt(" #n ")" ::: "memory")
#define PG8_WAIT_L(n) asm volatile("s_waitcnt lgkmcnt(" #n ")" ::: "memory")
#define PG8_BAR __builtin_amdgcn_s_barrier()
#define PG8_SCHED __builtin_amdgcn_sched_barrier(0)
    Unit cur, nxt; int ui = 0;
    if (!S.next(0, cur)) return;
    f32x4 acc[2][2][4][2];
#pragma unroll
    for (int a = 0; a < 2; ++a)
#pragma unroll
        for (int b = 0; b < 2; ++b)
#pragma unroll
            for (int m = 0; m < 4; ++m)
#pragma unroll
                for (int n = 0; n < 2; ++n) acc[a][b][m][n] = (f32x4){0.f, 0.f, 0.f, 0.f};
    bf16x8 At[4][2], B0[2][2], B1[2][2];
    const char* cA = (const char*)g.A + (size_t)cur.pm * tstep; const char* cB = (const char*)g.Bt + (size_t)cur.pn * tstep;
    S.a_ready(cur);
    if constexpr (SP2) {
        PG8_STAGE(PG8_SB(0, 0), cB, voffB); PG8_STAGE(PG8_SB(0, 1), cB + hstep, voffB); PG8_STAGE(PG8_SA(0, 0), cA, voffA); PG8_STAGE(PG8_SA(0, 1), cA + hstep, voffA);
        if (wr == 1) PG8_BAR;
        PG8_WAIT_V(2); PG8_BAR;
        PG8_STAGE(PG8_SB(1, 0), cB + kstep, voffB); PG8_STAGE(PG8_SA(1, 0), cA + kstep, voffA); PG8_STAGE(PG8_SB(1, 1), cB + hstep + kstep, voffB);
        PG8_WAIT_V(6); PG8_BAR;
    } else {
        PG8_STAGE(PG8_SB(0, 0), cB, voffB); PG8_STAGE(PG8_SA(0, 0), cA, voffA); PG8_STAGE(PG8_SB(0, 1), cB + hstep, voffB); PG8_STAGE(PG8_SA(0, 1), cA + hstep, voffA);
        if (wr == 1) PG8_BAR;
        PG8_WAIT_V(4); PG8_BAR;
        PG8_STAGE(PG8_SB(1, 0), cB + kstep, voffB); PG8_STAGE(PG8_SA(1, 0), cA + kstep, voffA); PG8_STAGE(PG8_SB(1, 1), cB + hstep + kstep, voffB);
        PG8_WAIT_V(6); PG8_BAR;
    }
    for (;;) {
        const bool has_next = S.next(ui + 1, nxt);
        const char* nA = has_next ? (const char*)g.A + (size_t)nxt.pm * tstep : cA; const char* nB = has_next ? (const char*)g.Bt + (size_t)nxt.pn * tstep : cB;
        for (int t = 0; t < nt; t += 2) {
            const bool last = (t == nt - 2);
            const char* a1 = cA + (size_t)(t + 1) * kstep;
            const char* a2 = last ? nA : cA + (size_t)(t + 2) * kstep; const char* b2 = last ? nB : cB + (size_t)(t + 2) * kstep;
            const char* a3 = a2 + kstep; const char* b3 = b2 + kstep;
            if (last && has_next) S.a_ready(nxt);
            if constexpr (SP2) {
            PG8_LDB(B0, 0, 0); PG8_LDB(B1, 0, 1); PG8_SCHED; PG8_LDA(At, 0, 0); PG8_STAGE(PG8_SA(1, 1), a1 + hstep, voffA);
            PG8_WAIT_V(8); PG8_WAIT_L(0); PG8_BAR; PG8_MMA(0, 0, At, B0); PG8_MMA(0, 1, At, B1); PG8_BAR; PG8_SCHED;
            PG8_LDA(At, 0, 1); PG8_STAGE(PG8_SB(0, 0), b2, voffB); PG8_STAGE(PG8_SB(0, 1), b2 + hstep, voffB); PG8_STAGE(PG8_SA(0, 0), a2, voffA);
            PG8_WAIT_V(8); PG8_WAIT_L(0); PG8_BAR; PG8_MMA(1, 0, At, B0); PG8_MMA(1, 1, At, B1); PG8_BAR; PG8_SCHED;
            PG8_LDB(B0, 1, 0); PG8_LDB(B1, 1, 1); PG8_SCHED; PG8_LDA(At, 1, 0); PG8_STAGE(PG8_SA(0, 1), a2 + hstep, voffA);
            PG8_WAIT_V(8); PG8_WAIT_L(0); PG8_BAR; PG8_MMA(0, 0, At, B0); PG8_MMA(0, 1, At, B1); PG8_BAR; PG8_SCHED;
            PG8_LDA(At, 1, 1); PG8_STAGE(PG8_SB(1, 0), b3, voffB); PG8_STAGE(PG8_SB(1, 1), b3 + hstep, voffB); PG8_STAGE(PG8_SA(1, 0), a3, voffA);
            PG8_WAIT_V(8); PG8_WAIT_L(0); PG8_BAR; PG8_MMA(1, 0, At, B0); PG8_MMA(1, 1, At, B1); PG8_BAR; PG8_SCHED;
            } else {
            PG8_LDB(B0, 0, 0); PG8_SCHED; PG8_LDA(At, 0, 0); PG8_STAGE(PG8_SA(1, 1), a1 + hstep, voffA);
            PG8_WAIT_L(8); PG8_BAR; PG8_WAIT_L(0); PG8_MMA(0, 0, At, B0); PG8_BAR; PG8_SCHED;
            PG8_LDB(B1, 0, 1); PG8_STAGE(PG8_SB(0, 0), b2, voffB);
            PG8_BAR; PG8_WAIT_L(0); PG8_MMA(0, 1, At, B1); PG8_BAR;
            PG8_LDA(At, 0, 1); PG8_STAGE(PG8_SA(0, 0), a2, voffA);
            PG8_BAR; PG8_WAIT_L(0); PG8_MMA(1, 0, At, B0); PG8_BAR; PG8_SCHED;
            PG8_STAGE(PG8_SB(0, 1), b2 + hstep, voffB);
            PG8_WAIT_V(6); PG8_BAR; PG8_MMA(1, 1, At, B1); PG8_BAR;
            PG8_LDB(B0, 1, 0); PG8_SCHED; PG8_LDA(At, 1, 0); PG8_STAGE(PG8_SA(0, 1), a2 + hstep, voffA);
            PG8_WAIT_L(8); PG8_BAR; PG8_WAIT_L(0); PG8_MMA(0, 0, At, B0); PG8_BAR; PG8_SCHED;
            PG8_LDB(B1, 1, 1); PG8_STAGE(PG8_SB(1, 0), b3, voffB);
            PG8_BAR; PG8_WAIT_L(0); PG8_MMA(0, 1, At, B1); PG8_BAR;
            PG8_LDA(At, 1, 1); PG8_STAGE(PG8_SA(1, 0), a3, voffA);
            PG8_BAR; PG8_WAIT_L(0); PG8_MMA(1, 0, At, B0); PG8_BAR; PG8_SCHED;
            PG8_STAGE(PG8_SB(1, 1), b3 + hstep, voffB);
            PG8_WAIT_V(6); PG8_BAR; PG8_MMA(1, 1, At, B1); PG8_BAR;
            }
        }
        if constexpr (ALIGN_EPI) { if (wr == 0) PG8_BAR; }
        if constexpr (!Epi::AFTER_DRAIN) { E(acc, cur, wr, wc, fr, fq); S.done(cur); }
        if (!has_next) break;
#pragma unroll
        for (int a = 0; a < 2; ++a)
#pragma unroll
            for (int b = 0; b < 2; ++b)
#pragma unroll
                for (int m = 0; m < 4; ++m)
#pragma unroll
                    for (int n = 0; n < 2; ++n) acc[a][b][m][n] = (f32x4){0.f, 0.f, 0.f, 0.f};
        cur = nxt; cA = nA; cB = nB; ++ui;
        if constexpr (ALIGN_EPI) { if (wr == 1) PG8_BAR; }
    }
    PG8_WAIT_V(0);
    if constexpr (!ALIGN_EPI) { if (wr == 0) PG8_BAR; }
    PG8_BAR;
#undef PG8_SA
#undef PG8_SB
#undef PG8_STAGE
#undef PG8_LDA
#undef PG8_LDB
#undef PG8_MMA
#undef PG8_WAIT_V
#undef PG8_WAIT_L
#undef PG8_BAR
#undef PG8_SCHED
}
}

__device__ __forceinline__ void transpose_item(const float* W, int K, int N, bf16_t* WT, int drow0, const float* gk, float cs, LAS float* scr, int kb, int nb, int lane) {
    const int k0 = 64 * kb, n0 = 32 * nb;
#pragma unroll
    for (int i = 0; i < 32; ++i) { const int kk = 2 * i + (lane >> 5); const float gsc = gk ? gk[k0 + kk] * cs : cs; scr[kk * 33 + (lane & 31)] = W[(size_t)(k0 + kk) * N + n0 + (lane & 31)] * gsc; }
    asm volatile("s_waitcnt lgkmcnt(0)" ::: "memory");
    const int c = lane & 7;
#pragma unroll
    for (int j = 0; j < 4; ++j) { const int n = (lane >> 3) + 8 * j; const LAS float* s = scr + (8 * c) * 33 + n;
        u32x4 o; o.x = cvt_pk_bf16(s[0 * 33], s[1 * 33]); o.y = cvt_pk_bf16(s[2 * 33], s[3 * 33]); o.z = cvt_pk_bf16(s[4 * 33], s[5 * 33]); o.w = cvt_pk_bf16(s[6 * 33], s[7 * 33]);
        *(u32x4*)(WT + (size_t)(drow0 + n) * K + k0 + 8 * c) = o; }
    asm volatile("s_waitcnt lgkmcnt(0)" ::: "memory");
}

struct Args { const float* in[15]; float* out; unsigned char* ws; };

__device__ __forceinline__ void attn_item(LAS unsigned char* lds, const bf16_t* PROJ, bf16_t* MIX, const float* rpb_l, int item, int tid, int wid, int lane) {
    const int b = item >> 3, h = item & 7, fr = lane & 15, fq = lane >> 4;
    LAS unsigned char* Kl = lds; LAS unsigned char* Vl = lds + 73728; LAS float* bias = (LAS float*)(lds + 147456);
    for (int i = tid; i < 480; i += 512) { const int dr_ = i >> 5, dc_ = i & 31; bias[i] = dc_ < 31 ? rpb_l[h * 465 + dr_ * 31 + dc_] * 1.44269504f : -INFINITY; }
    const bf16_t* base = PROJ + (size_t)b * SEQ * INW + h * 64;
    const int lkey = tid >> 2, lcp = tid & 3, lrow = lkey >> 6, lkc = lkey & 63;
    u32x4 kreg0, kreg1, vreg0, vreg1;
    kreg0 = kreg1 = vreg0 = vreg1 = (u32x4){0u, 0u, 0u, 0u};
#define ATT_LOAD(row_lo, cnt) do { if (lrow < (cnt)) { const bf16_t* p_ = base + (size_t)(((row_lo) + lrow) * 64 + lkc) * INW + C_K + lcp * 16; \
        kreg0 = *(const u32x4*)p_; kreg1 = *(const u32x4*)(p_ + 8); vreg0 = *(const u32x4*)(p_ + 512); vreg1 = *(const u32x4*)(p_ + 520); } } while (0)
#define ATT_STORE(row_lo, cnt) do { if (lrow < (cnt)) { const int slot_ = ((row_lo) + lrow) % 9; const int sw_ = (lkc >> 1) & 7; \
        LAS unsigned char* kp_ = Kl + slot_ * 8192 + lkc * 128; \
        *(LAS u32x4*)(kp_ + (((2 * lcp) ^ sw_) << 4)) = kreg0; *(LAS u32x4*)(kp_ + (((2 * lcp + 1) ^ sw_) << 4)) = kreg1; \
        LAS unsigned char* vp_ = Vl + slot_ * 8192 + (lkc & 3) * 2; const int c8_ = lkc >> 2; \
        _Pragma("unroll") for (int e_ = 0; e_ < 8; ++e_) { const int d0_ = lcp * 16 + e_, d1_ = d0_ + 8; \
            const unsigned x0_ = (vreg0[e_ >> 1] >> (16 * (e_ & 1))) & 0xffffu, x1_ = (vreg1[e_ >> 1] >> (16 * (e_ & 1))) & 0xffffu; \
            *(LAS unsigned short*)(vp_ + d0_ * 128 + ((c8_ ^ (((d0_ >> 1) & 7) << 1)) << 3)) = (unsigned short)x0_; \
            *(LAS unsigned short*)(vp_ + d1_ * 128 + ((c8_ ^ (((d1_ >> 1) & 7) << 1)) << 3)) = (unsigned short)x1_; } } } while (0)
    for (int q = 0; q < 4; ++q) { ATT_LOAD(2 * q, 2); ATT_STORE(2 * q, 2); }
    int loaded = 8;
    __syncthreads();
    const int j = wid & 3, bs = min(max(16 * j - 8, 0), 32), qc = 16 * j + fr, wsq = min(max(qc - 8, 0), 48);
    const bf16_t* qbase = PROJ + ((size_t)b * SEQ + (wid >> 2) * 64 + qc) * INW + C_Q + h * 64 + fq * 8;
    bf16x8 bq0 = *(const bf16x8*)qbase, bq1 = *(const bf16x8*)(qbase + 32);
    int boff[8];
#pragma unroll
    for (int k = 0; k < 8; ++k) { const int kc = bs + 16 * (k >> 2) + 4 * fq + (k & 3); const bool inw = (kc >= wsq) && (kc < wsq + 16); boff[k] = (inw ? (kc - qc + 15) : 31) * 4; }
#pragma unroll 1
    for (int s = 0; s < 16; ++s) {
        const int need_next = (s < 15) ? (min(max(2 * (s + 1) - 3, 0), 24) + 8) : loaded;
        const int cnt = need_next - loaded;
        ATT_LOAD(loaded, cnt);
        {
            const int r = 2 * s + (wid >> 2), rs = min(max(r - 4, 0), 24);
            const size_t qtok = (size_t)b * SEQ + r * 64 + qc;
            const bf16_t* qn = qbase + (size_t)(s < 15 ? s + 1 : s) * 128 * INW;
            const bf16x8 bqn0 = *(const bf16x8*)qn, bqn1 = *(const bf16x8*)(qn + 32);
            f32x4 S[16];
            int slot = rs % 9;
            const int slot0 = slot;
#pragma unroll
            for (int i = 0; i < 8; ++i) {
#pragma unroll
                for (int hf = 0; hf < 2; ++hf) {
                    const int kc = bs + 16 * hf + fr, sw = (kc >> 1) & 7;
                    const LAS unsigned char* kp = Kl + slot * 8192 + kc * 128;
                    const bf16x8 a0 = *(const LAS bf16x8*)(kp + ((fq ^ sw) << 4)), a1 = *(const LAS bf16x8*)(kp + (((fq + 4) ^ sw) << 4));
                    f32x4 acc = (f32x4){0.f, 0.f, 0.f, 0.f};
                    acc = __builtin_amdgcn_mfma_f32_16x16x32_bf16(a0, bq0, acc, 0, 0, 0);
                    acc = __builtin_amdgcn_mfma_f32_16x16x32_bf16(a1, bq1, acc, 0, 0, 0);
                    S[2 * i + hf] = acc;
                }
                slot = (slot == 8) ? 0 : slot + 1;
            }
            float mx = -INFINITY;
            const LAS unsigned char* brow = (const LAS unsigned char*)bias + (rs - r + 7) * 128;
#pragma unroll
            for (int i = 0; i < 8; ++i)
#pragma unroll
                for (int k = 0; k < 8; ++k) { const float v = S[2 * i + (k >> 2)][k & 3] + *(const LAS float*)(brow + i * 128 + boff[k]); S[2 * i + (k >> 2)][k & 3] = v; mx = fmaxf(mx, v); }
            mx = fmaxf(mx, __shfl_xor(mx, 16)); mx = fmaxf(mx, __shfl_xor(mx, 32));
            float l = 0.f;
#pragma unroll
            for (int g = 0; g < 16; ++g)
#pragma unroll
                for (int e = 0; e < 4; ++e) { const float p = __builtin_amdgcn_exp2f(S[g][e] - mx); S[g][e] = p; l += p; }
            l += __shfl_xor(l, 16); l += __shfl_xor(l, 32);
            f32x4 o[4];
#pragma unroll
            for (int dg = 0; dg < 4; ++dg) o[dg] = (f32x4){0.f, 0.f, 0.f, 0.f};
            slot = slot0;
#pragma unroll
            for (int i = 0; i < 8; ++i) {
                u32x4 pw; pw.x = cvt_pk_bf16(S[2 * i][0], S[2 * i][1]); pw.y = cvt_pk_bf16(S[2 * i][2], S[2 * i][3]); pw.z = cvt_pk_bf16(S[2 * i + 1][0], S[2 * i + 1][1]); pw.w = cvt_pk_bf16(S[2 * i + 1][2], S[2 * i + 1][3]);
                const bf16x8 pb = __builtin_bit_cast(bf16x8, pw);
#pragma unroll
                for (int dg = 0; dg < 4; ++dg) { const int d = 16 * dg + fr, swv = ((d >> 1) & 7) << 1, cA = (bs >> 2) + fq, cB = cA + 4;
                    const LAS unsigned char* vp = Vl + slot * 8192 + d * 128;
                    const u32x2 lo = *(const LAS u32x2*)(vp + ((cA ^ swv) << 3)), hi = *(const LAS u32x2*)(vp + ((cB ^ swv) << 3));
                    const u32x4 aw = (u32x4){lo.x, lo.y, hi.x, hi.y};
                    o[dg] = __builtin_amdgcn_mfma_f32_16x16x32_bf16(__builtin_bit_cast(bf16x8, aw), pb, o[dg], 0, 0, 0); }
                slot = (slot == 8) ? 0 : slot + 1;
            }
            const float inv = __builtin_amdgcn_rcpf(l);
#pragma unroll
            for (int dg = 0; dg < 4; ++dg) o[dg] = o[dg] * inv;
            headnorm_store(o, MIX + qtok * DM + h * 64 + 4 * fq);
            bq0 = bqn0; bq1 = bqn1;
        }
        __syncthreads();
        ATT_STORE(loaded, cnt); loaded += cnt;
        __syncthreads();
    }
#undef ATT_LOAD
#undef ATT_STORE
}

__device__ __forceinline__ void gate_item(LAS unsigned char* lds, const bf16_t* PROJ, bf16_t* MIX, const float* lng, const float* lnb, const bf16_t* wsb, const float* bsp, int item, int wid, int lane) {
    const int fr = lane & 15, fq = lane >> 4;
    const size_t tok0 = (size_t)item * 128;
    constexpr int PITCH = 272;
    float g4[4], b4[4];
#pragma unroll
    for (int i = 0; i < 4; ++i) { g4[i] = lng[lane + 64 * i]; b4[i] = lnb[lane + 64 * i]; }
#pragma unroll 1
    for (int t0 = 0; t0 < 16; t0 += 4) {
        float v[4][4], s[4], s2[4];
#pragma unroll
        for (int uu = 0; uu < 4; ++uu) { const bf16_t* zp = PROJ + (tok0 + 16 * wid + t0 + uu) * INW + C_VG;
#pragma unroll
            for (int i = 0; i < 4; ++i) v[uu][i] = bf2f(zp[lane + 64 * i]); }
#pragma unroll
        for (int uu = 0; uu < 4; ++uu) { s[uu] = 0.f;
#pragma unroll
            for (int i = 0; i < 4; ++i) { v[uu][i] = gelu_tanh(v[uu][i]); s[uu] += v[uu][i]; } }
#pragma unroll
        for (int o = 1; o < 64; o <<= 1)
#pragma unroll
            for (int uu = 0; uu < 4; ++uu) s[uu] += __shfl_xor(s[uu], o);
#pragma unroll
        for (int uu = 0; uu < 4; ++uu) { const float mean = s[uu] * (1.0f / 256.0f); s2[uu] = 0.f;
#pragma unroll
            for (int i = 0; i < 4; ++i) { v[uu][i] -= mean; s2[uu] += v[uu][i] * v[uu][i]; } }
#pragma unroll
        for (int o = 1; o < 64; o <<= 1)
#pragma unroll
            for (int uu = 0; uu < 4; ++uu) s2[uu] += __shfl_xor(s2[uu], o);
#pragma unroll
        for (int uu = 0; uu < 4; ++uu) { const float rstd = rsqrtf(s2[uu] * (1.0f / 256.0f) + EPS); const int q = 16 * wid + t0 + uu;
#pragma unroll
            for (int i = 0; i < 4; ++i) { const float y = v[uu][i] * rstd * g4[i] + b4[i]; *(LAS unsigned short*)(lds + (lane + 64 * i) * PITCH + q * 2) = (unsigned short)(cvt_pk_bf16(y, 0.f) & 0xffffu); } }
    }
    __syncthreads();
    const int hh = wid >> 1, ph = wid & 1;
#pragma unroll 2
    for (int pt4 = 0; pt4 < 4; ++pt4) { const int p = 16 * (4 * ph + pt4) + fr;
        bf16x8 B[4];
#pragma unroll
        for (int ks = 0; ks < 4; ++ks) B[ks] = *(const bf16x8*)(wsb + (size_t)(hh * 128 + p) * 128 + 32 * ks + 8 * fq);
        f32x4 o[4];
#pragma unroll
        for (int dg = 0; dg < 4; ++dg) { f32x4 acc = (f32x4){0.f, 0.f, 0.f, 0.f};
#pragma unroll
            for (int ks = 0; ks < 4; ++ks) { const bf16x8 A = *(const LAS bf16x8*)(lds + (64 * hh + 16 * dg + fr) * PITCH + (32 * ks + 8 * fq) * 2); acc = __builtin_amdgcn_mfma_f32_16x16x32_bf16(A, B[ks], acc, 0, 0, 0); }
            o[dg] = acc; }
        const size_t tok = tok0 + (16 * (4 * ph + pt4)) + (lane >> 4) * 0 + 0;
        const size_t mytok = tok + fr;
        const float bsv = bsp[hh * 128 + p];
        const bf16_t* up = PROJ + mytok * INW + C_U + 64 * hh + 4 * fq;
#pragma unroll
        for (int dg = 0; dg < 4; ++dg) { const u32x2 uw = *(const u32x2*)(up + 16 * dg);
            const float u0 = gelu_tanh(bf2f(uw.x & 0xffffu)), u1 = gelu_tanh(bf2f(uw.x >> 16)), u2 = gelu_tanh(bf2f(uw.y & 0xffffu)), u3 = gelu_tanh(bf2f(uw.y >> 16));
            o[dg][0] = u0 * (o[dg][0] + bsv); o[dg][1] = u1 * (o[dg][1] + bsv); o[dg][2] = u2 * (o[dg][2] + bsv); o[dg][3] = u3 * (o[dg][3] + bsv); }
        headnorm_store(o, MIX + mytok * DM + 512 + 64 * hh + 4 * fq);
    }
    __syncthreads();
}

__device__ __forceinline__ void chan_dft(LAS unsigned char* lds, const bf16_t* PROJ, bf16_t* ABT, int tid, int gw, int ngw, int lane) {
    const int fr = lane & 15, fq = lane >> 4;
    LAS bf16_t* Ct = (LAS bf16_t*)lds; LAS bf16_t* St = (LAS bf16_t*)(lds + 9216);
    for (int idx = tid; idx < 4096; idx += 512) { const int cp = idx >> 6, c = idx & 63; const float ph = (float)((cp * c) & 63) * (1.0f / 32.0f);
        Ct[cp * 72 + c] = (bf16_t)(cvt_pk_bf16(cospif(ph) * 0.125f, 0.f) & 0xffffu); St[cp * 72 + c] = (bf16_t)(cvt_pk_bf16(sinpif(ph) * 0.125f, 0.f) & 0xffffu); }
    __syncthreads();
#pragma unroll 1
    for (int it = gw; it < MTOK / 16; it += ngw) { const size_t tok0 = (size_t)it * 16; const int b = (int)(tok0 >> 11), n0 = (int)(tok0 & 2047);
#pragma unroll
        for (int gi = 0; gi < 4; ++gi) {
            const bf16_t* xp = PROJ + (tok0 + fr) * INW + C_XC + 64 * gi + 8 * fq;
            const bf16x8 A0 = *(const bf16x8*)xp, A1 = *(const bf16x8*)(xp + 32);
#pragma unroll
            for (int ct = 0; ct < 4; ++ct) { const int cc = 16 * ct + fr;
                const bf16x8 Bc0 = *(const LAS bf16x8*)(Ct + cc * 72 + 8 * fq), Bc1 = *(const LAS bf16x8*)(Ct + cc * 72 + 32 + 8 * fq);
                const bf16x8 Bs0 = *(const LAS bf16x8*)(St + cc * 72 + 8 * fq), Bs1 = *(const LAS bf16x8*)(St + cc * 72 + 32 + 8 * fq);
                f32x4 aC = (f32x4){0.f, 0.f, 0.f, 0.f}, aS = (f32x4){0.f, 0.f, 0.f, 0.f};
                aC = __builtin_amdgcn_mfma_f32_16x16x32_bf16(A0, Bc0, aC, 0, 0, 0); aC = __builtin_amdgcn_mfma_f32_16x16x32_bf16(A1, Bc1, aC, 0, 0, 0);
                aS = __builtin_amdgcn_mfma_f32_16x16x32_bf16(A0, Bs0, aS, 0, 0, 0); aS = __builtin_amdgcn_mfma_f32_16x16x32_bf16(A1, Bs1, aS, 0, 0, 0);
                const int rho = 128 * (cc >> 5) + 32 * gi + (cc & 31);
                bf16_t* dst = ABT + ((size_t)b * 256 + rho) * 4096 + n0 + 4 * fq;
                u32x2 wc_, ws_; wc_.x = cvt_pk_bf16(aC[0], aC[1]); wc_.y = cvt_pk_bf16(aC[2], aC[3]); ws_.x = cvt_pk_bf16(aS[0], aS[1]); ws_.y = cvt_pk_bf16(aS[2], aS[3]);
                *(u32x2*)dst = wc_; *(u32x2*)(dst + 2048) = ws_; }
        }
    }
    __syncthreads();
}

#define XB_TMO      128
#define XB_XCNT(j)  (256  + 64 * (j))
#define XB_XSUB(j)  (1280 + 64 * (j))
#define XB_XGEN(j)  (2304 + 64 * (j))
#define XB_TOP      3328
#define XB_TOPGEN   3392
#define XCD_BAR_WORDS 3456
#define XB_SPIN_CAP (1u << 18)
__device__ __forceinline__ unsigned xb_ld(unsigned* p)              { return __hip_atomic_load(p, __ATOMIC_RELAXED, __HIP_MEMORY_SCOPE_AGENT); }
__device__ __forceinline__ unsigned xb_add(unsigned* p, unsigned v) { return __hip_atomic_fetch_add(p, v, __ATOMIC_RELAXED, __HIP_MEMORY_SCOPE_AGENT); }
__device__ __forceinline__ unsigned xb_xcc_id() { return (unsigned)__builtin_amdgcn_s_getreg((3 << 11) | 20) & 0xFu; }
#define XB_SPIN(cond, bar) do { unsigned _sp = 0; while (cond) { __builtin_amdgcn_s_sleep(1); \
    if ((++_sp & 255u) == 0u) { if (xb_ld(&(bar)[XB_TMO])) break; if (_sp > XB_SPIN_CAP) { atomicAdd(&(bar)[XB_TMO], 1u); break; } } } } while (0)
struct XcdBarrier { unsigned* bar; unsigned x; volatile LAS unsigned* st; };
__device__ __forceinline__ XcdBarrier xcd_barrier_post(unsigned* bar, volatile LAS unsigned* st) {
    XcdBarrier b; b.bar = bar; b.x = xb_xcc_id(); b.st = st;
    if (threadIdx.x == 0) (void)xb_add(&bar[XB_XCNT(b.x)], 1u);
    return b;
}
__device__ __forceinline__ void xcd_barrier_complete(unsigned* bar, unsigned x, unsigned& nloc, unsigned& nx) {
    const unsigned G = gridDim.x * gridDim.y * gridDim.z;
    unsigned sum, cnt, mine, sp = 0u;
    for (;;) {
        sum = 0u; cnt = 0u; mine = 0u;
#pragma unroll
        for (unsigned j = 0; j < 16; ++j) { const unsigned c = xb_ld(&bar[XB_XCNT(j)]); sum += c; cnt += (c > 0u) ? 1u : 0u; mine = (j == x) ? c : mine; }
        if (sum == G) break;
        __builtin_amdgcn_s_sleep(1);
        if ((++sp & 255u) == 0u) { if (xb_ld(&bar[XB_TMO])) break; if (sp > XB_SPIN_CAP) { atomicAdd(&bar[XB_TMO], 1u); break; } }
    }
    nloc = mine > 0u ? mine : 1u; nx = cnt > 0u ? cnt : 1u;
}
__device__ __forceinline__ void xcd_barrier(const XcdBarrier& b) {
    asm volatile("s_waitcnt vmcnt(0)" ::: "memory");
    __syncthreads();
    if (threadIdx.x == 0) {
        unsigned* bar = b.bar;
        __builtin_amdgcn_s_waitcnt(0);
        unsigned nloc = b.st[0], nx = b.st[1];
        if (nloc == 0u) { xcd_barrier_complete(bar, b.x, nloc, nx); b.st[0] = nloc; b.st[1] = nx; }
        const unsigned old = xb_add(&bar[XB_XSUB(b.x)], 1u);
        const unsigned gen = old / nloc;
        if (old + 1u == (gen + 1u) * nloc) {
            __builtin_amdgcn_fence(__ATOMIC_RELEASE, "agent");
            asm volatile("s_waitcnt vmcnt(0)" ::: "memory");
            const unsigned og = xb_add(&bar[XB_TOP], 1u);
            const unsigned tg = og / nx;
            if (og + 1u == (tg + 1u) * nx) xb_add(&bar[XB_TOPGEN], 1u);
            else XB_SPIN(xb_ld(&bar[XB_TOPGEN]) == tg, bar);
            __builtin_amdgcn_fence(__ATOMIC_ACQUIRE, "agent");
            xb_add(&bar[XB_XGEN(b.x)], 1u);
            asm volatile("s_waitcnt vmcnt(0)" ::: "memory");
        } else {
            XB_SPIN(xb_ld(&bar[XB_XGEN(b.x)]) == gen, bar);
            __builtin_amdgcn_fence(__ATOMIC_ACQUIRE, "agent");
            asm volatile("s_waitcnt vmcnt(0)" ::: "memory");
        }
    }
    __syncthreads();
}
#define GRID_SYNC() xcd_barrier(xbar)

template <int l>
__device__ __forceinline__ void layer_body(const Args& a, LAS unsigned char* lds, const XcdBarrier& xbar) {
    int t_ = threadIdx.x; asm volatile("" : "+v"(t_));
    const int tid = t_, lane = tid & 63, wid = __builtin_amdgcn_readfirstlane(tid >> 6);
    const int G = gridDim.x, bx = blockIdx.x;
    const int gw = bx * 8 + wid, ngw = G * 8;
    unsigned char* ws = a.ws;
    const float* x_in = a.in[0];
    float* out = a.out;
    bf16_t* WIN = (bf16_t*)(ws + WS_WIN); bf16_t* WOUT = (bf16_t*)(ws + WS_WOUT); bf16_t* WGU = (bf16_t*)(ws + WS_WGU); bf16_t* WDN = (bf16_t*)(ws + WS_WDN);
    bf16_t* WSP = (bf16_t*)(ws + WS_WSP); bf16_t* TT = (bf16_t*)(ws + WS_T); u64* RSB = (u64*)(ws + WS_SSQ); u64* RSA = RSB + MTOK; const float* SSQ = (const float*)RSB;
    bf16_t* XB = (bf16_t*)(ws + WS_XB); bf16_t* ABT = (bf16_t*)(ws + WS_ABT); bf16_t* PROJ = (bf16_t*)(ws + WS_PROJ); bf16_t* MIX = (bf16_t*)(ws + WS_MIX); bf16_t* HID = (bf16_t*)(ws + WS_HID);
        { pg8::Gemm g{XB, WIN + (size_t)l * INW * DM, MTOK, INW, DM}; pg8::StaticOrder S; S.init(MTOK, INW, G, bx);
          pg8::EpiProj E{PROJ, INW, RSB};
          pg8::gemm_phase<pg8::EpiProj, pg8::StaticOrder, true, true>(lds, g, S, E); }
        GRID_SYNC();
        for (int i = bx * 512 + tid; i < 2 * MTOK; i += G * 512) RSB[i] = 0ull;
        for (int it = bx; it < NBATCH * 8; it += G) attn_item(lds, PROJ, MIX, a.in[3] + (size_t)l * 8 * 465, it, tid, wid, lane);
        for (int it = bx; it < NBATCH * 16; it += G) gate_item(lds, PROJ, MIX, a.in[4] + l * 256, a.in[5] + l * 256, WSP + (size_t)l * 4 * 128 * 128, a.in[7] + l * 512, it, wid, lane);
        chan_dft(lds, PROJ, ABT, tid, gw, ngw, lane);
        GRID_SYNC();
        { pg8::Gemm g{TT, ABT, 2048, 8192, 4096}; pg8::DftOrder S; S.init(G, bx);
          pg8::EpiDft E{MIX};
          pg8::gemm_phase<pg8::EpiDft, pg8::DftOrder, true, true>(lds, g, S, E); }
        GRID_SYNC();
        { pg8::Gemm g{MIX, WOUT + (size_t)l * DM * DM, MTOK, DM, DM}; pg8::StaticOrder S; S.init(MTOK, DM, G, bx);
          pg8::EpiRes E{XB, RSA};
          pg8::gemm_phase<pg8::EpiRes, pg8::StaticOrder, true, true>(lds, g, S, E); }
        GRID_SYNC();
        { pg8::Gemm g{XB, WGU + (size_t)l * NGU * DM, MTOK, NGU, DM}; pg8::StaticOrder S; S.init(MTOK, NGU, G, bx);
          pg8::EpiGU E{HID, RSA};
          pg8::gemm_phase<pg8::EpiGU, pg8::StaticOrder, true, true>(lds, g, S, E); }
        GRID_SYNC();
        { pg8::Gemm g{HID, WDN + (size_t)l * DM * DFF, MTOK, DM, DFF}; pg8::StaticOrder S; S.init(MTOK, DM, G, bx);
          pg8::EpiRes E{XB, RSB};
          pg8::gemm_phase<pg8::EpiRes, pg8::StaticOrder, true, true>(lds, g, S, E); }
        GRID_SYNC();
}

__global__ void __launch_bounds__(512, 2) fwd_megakernel(Args a) {
    extern __shared__ __attribute__((aligned(16))) unsigned char lds_raw[];
    LAS unsigned char* lds = (LAS unsigned char*)lds_raw;
    cg::grid_group grid = cg::this_grid();
    volatile LAS unsigned* bst = (volatile LAS unsigned*)(lds + LDS_BYTES - 16);
    if (threadIdx.x == 0) { bst[0] = 0u; bst[1] = 0u; }
    __syncthreads();
    const XcdBarrier xbar = xcd_barrier_post((unsigned*)(a.ws + WS_CTL), bst);
    const int tid = threadIdx.x, lane = tid & 63, wid = __builtin_amdgcn_readfirstlane(tid >> 6);
    const int G = gridDim.x, bx = blockIdx.x;
    const int gw = bx * 8 + wid, ngw = G * 8;
    unsigned char* ws = a.ws;
    const float* x_in = a.in[0];
    float* out = a.out;
    bf16_t* WIN = (bf16_t*)(ws + WS_WIN); bf16_t* WOUT = (bf16_t*)(ws + WS_WOUT); bf16_t* WGU = (bf16_t*)(ws + WS_WGU); bf16_t* WDN = (bf16_t*)(ws + WS_WDN);
    bf16_t* WSP = (bf16_t*)(ws + WS_WSP); bf16_t* TT = (bf16_t*)(ws + WS_T); u64* RSB = (u64*)(ws + WS_SSQ); u64* RSA = RSB + MTOK; const float* SSQ = (const float*)RSB;
    bf16_t* XB = (bf16_t*)(ws + WS_XB); bf16_t* ABT = (bf16_t*)(ws + WS_ABT); bf16_t* PROJ = (bf16_t*)(ws + WS_PROJ); bf16_t* MIX = (bf16_t*)(ws + WS_MIX); bf16_t* HID = (bf16_t*)(ws + WS_HID);

    {
        LAS float* scr = (LAS float*)(lds + wid * 8448);
        constexpr int I_IN = 16 * 72, I_OUT = 16 * 32, I_G = 16 * 88, I_D = 44 * 32, I_L = I_IN + I_OUT + 2 * I_G + I_D;
#pragma unroll 1
        for (int it = gw; it < DEPTH * I_L; it += ngw) {
            const int l = it / I_L; int r = it % I_L;
            if (r < I_IN) { const int kb = r / 72, nb = r % 72; transpose_item(a.in[2] + (size_t)l * DM * INW, DM, INW, WIN + (size_t)l * INW * DM, 32 * nb, a.in[1] + l * DM, (32 * nb < 512) ? 0.125f * 1.44269504f : 1.0f, scr, kb, nb, lane); continue; }
            r -= I_IN;
            if (r < I_OUT) { const int kb = r / 32, nb = r % 32; transpose_item(a.in[9] + (size_t)l * DM * DM, DM, DM, WOUT + (size_t)l * DM * DM, 32 * nb, a.in[8] + l * DM, 1.0f, scr, kb, nb, lane); continue; }
            r -= I_OUT;
            if (r < I_G) { const int kb = r / 88, nb = r % 88, n0 = 32 * nb; transpose_item(a.in[11] + (size_t)l * DM * DFF, DM, DFF, WGU + (size_t)l * NGU * DM, (n0 >> 7) * 256 + (n0 & 127), a.in[10] + l * DM, 1.0f, scr, kb, nb, lane); continue; }
            r -= I_G;
            if (r < I_G) { const int kb = r / 88, nb = r % 88, n0 = 32 * nb; transpose_item(a.in[12] + (size_t)l * DM * DFF, DM, DFF, WGU + (size_t)l * NGU * DM, (n0 >> 7) * 256 + 128 + (n0 & 127), a.in[10] + l * DM, 1.0f, scr, kb, nb, lane); continue; }
            r -= I_G;
            { const int kb = r / 32, nb = r % 32; transpose_item(a.in[13] + (size_t)l * DFF * DM, DFF, DM, WDN + (size_t)l * DM * DFF, 32 * nb, nullptr, 1.0f, scr, kb, nb, lane); }
        }
        for (int i = bx * 512 + tid; i < DEPTH * 4 * 128 * 128 / 2; i += G * 512) { const float2 v = ((const float2*)a.in[6])[i]; ((unsigned*)WSP)[i] = cvt_pk_bf16(v.x, v.y); }
#pragma unroll 1
        for (int i = bx * 512 + tid; i < 2048 * 4096 / 8; i += G * 512) { const int k = i >> 9, n8 = (i & 511) * 8; const bool sn = n8 >= 2048; const int nb = n8 & 2047;
            float v[8];
#pragma unroll
            for (int e = 0; e < 8; ++e) { const float ph = (float)((k * (nb + e)) & 2047) * (1.0f / 1024.0f); v[e] = (sn ? -sinpif(ph) : cospif(ph)) * 0.022097086912f; }
            u32x4 w; w.x = cvt_pk_bf16(v[0], v[1]); w.y = cvt_pk_bf16(v[2], v[3]); w.z = cvt_pk_bf16(v[4], v[5]); w.w = cvt_pk_bf16(v[6], v[7]);
            *(u32x4*)(TT + (size_t)k * 4096 + n8) = w; }
#pragma unroll 1
        for (int m0 = gw; m0 < MTOK; m0 += 4 * ngw) { f32x4 v[4][4];
#pragma unroll
            for (int q = 0; q < 4; ++q) { const f32x4* xr = (const f32x4*)(x_in + (size_t)(m0 + q * ngw) * DM) + lane;
#pragma unroll
                for (int jj = 0; jj < 4; ++jj) v[q][jj] = xr[64 * jj]; }
#pragma unroll
            for (int q = 0; q < 4; ++q) { const int m = m0 + q * ngw; float s = 0.f; u32x2* o8 = (u32x2*)(XB + (size_t)m * DM) + lane;
#pragma unroll
                for (int jj = 0; jj < 4; ++jj) { const f32x4 t = v[q][jj]; s += (t[0] * t[0] + t[1] * t[1]) + (t[2] * t[2] + t[3] * t[3]); u32x2 w; w.x = cvt_pk_bf16(t[0], t[1]); w.y = cvt_pk_bf16(t[2], t[3]); o8[64 * jj] = w; }
                s = wave_sum(s);
                if (lane == 0) RSB[m] = (u64)(s * RSS_SCALE); } }
    }
    GRID_SYNC();

    layer_body<0>(a, lds, xbar);
    layer_body<1>(a, lds, xbar); layer_body<2>(a, lds, xbar); layer_body<3>(a, lds, xbar);
    {
        const float* fg = a.in[14];
        f32x4 gv[4];
#pragma unroll
        for (int jj = 0; jj < 4; ++jj) gv[jj] = ((const f32x4*)fg)[lane + 64 * jj];
#pragma unroll 1
        for (int m0 = gw; m0 < MTOK; m0 += 4 * ngw) { u32x2 v[4][4];
#pragma unroll
            for (int q = 0; q < 4; ++q) { const u32x2* xr = (const u32x2*)(XB + (size_t)(m0 + q * ngw) * DM) + lane;
#pragma unroll
                for (int jj = 0; jj < 4; ++jj) v[q][jj] = xr[64 * jj]; }
#pragma unroll
            for (int q = 0; q < 4; ++q) { f32x4* xr = (f32x4*)(out + (size_t)(m0 + q * ngw) * DM) + lane; float s = 0.f; f32x4 t[4];
#pragma unroll
                for (int jj = 0; jj < 4; ++jj) { t[jj] = (f32x4){bf2f(v[q][jj].x & 0xffffu), bf2f(v[q][jj].x >> 16), bf2f(v[q][jj].y & 0xffffu), bf2f(v[q][jj].y >> 16)}; s += (t[jj][0] * t[jj][0] + t[jj][1] * t[jj][1]) + (t[jj][2] * t[jj][2] + t[jj][3] * t[jj][3]); }
                const float rs = rsqrtf(wave_sum(s) * (1.0f / 1024.0f) + EPS);
#pragma unroll
                for (int jj = 0; jj < 4; ++jj) xr[64 * jj] = t[jj] * rs * gv[jj]; } }
    }
    grid.sync();
}

extern "C" void kernel_launch(void* const* d_in, const int* in_sizes, int n_in, void* d_out, int out_size, void* d_ws, size_t ws_size, hipStream_t stream) {
    static int grid = 0;
    if (grid == 0) {
        if (n_in != 15 || in_sizes[0] != MTOK * DM || out_size != MTOK * DM || ws_size < WS_END) { fprintf(stderr, "kernel_launch: unexpected shapes (n_in %d, in0 %d, out %d, ws %zu)\n", n_in, n_in > 0 ? in_sizes[0] : -1, out_size, ws_size); grid = -1; return; }
        int dev = 0, cus = 0, per_cu = 0;
        hipGetDevice(&dev);
        hipDeviceGetAttribute(&cus, hipDeviceAttributeMultiprocessorCount, dev);
        if (hipFuncSetAttribute((const void*)fwd_megakernel, hipFuncAttributeMaxDynamicSharedMemorySize, LDS_BYTES) != hipSuccess) { fprintf(stderr, "kernel_launch: hipFuncSetAttribute(%d B dynamic LDS) failed\n", LDS_BYTES); grid = -1; return; }
        if (hipOccupancyMaxActiveBlocksPerMultiprocessor(&per_cu, (const void*)fwd_megakernel, 512, LDS_BYTES) != hipSuccess || per_cu < 1) { fprintf(stderr, "kernel_launch: occupancy query says %d blocks per CU\n", per_cu); (void)hipGetLastError(); per_cu = 1; }
        grid = cus * per_cu;
        fprintf(stderr, "kernel_launch: grid %d (cus %d x %d)\n", grid, cus, per_cu);
    }
    if (grid < 0) return;
    if (hipMemsetAsync((char*)d_ws + WS_CTL, 0, 16384, stream) != hipSuccess) { fprintf(stderr, "kernel_launch: memset of the barrier word failed\n"); return; }
    Args a{};
    for (int i = 0; i < 15; ++i) a.in[i] = (const float*)d_in[i];
    a.out = (float*)d_out; a.ws = (unsigned char*)d_ws;
    void* args[] = {&a};
    hipError_t e = hipLaunchCooperativeKernel((const void*)fwd_megakernel, dim3(grid), dim3(512), args, LDS_BYTES, stream);
    if (e != hipSuccess) fprintf(stderr, "cooperative launch failed: %s (grid %d)\n", hipGetErrorString(e), grid);
}
```

```cpp
#include <hip/hip_runtime.h>
#include <hip/hip_cooperative_groups.h>
#include <cstdio>
#include <cstdint>
namespace cg = cooperative_groups;

#define LAS __attribute__((address_space(3)))
typedef unsigned short bf16_t;
typedef short bf16x8 __attribute__((ext_vector_type(8)));
typedef float f32x4 __attribute__((ext_vector_type(4)));
typedef unsigned u32x4 __attribute__((ext_vector_type(4)));
typedef unsigned u32x2 __attribute__((ext_vector_type(2)));

constexpr int DM = 1024, NBATCH = 32, SEQ = 2048, DEPTH = 4, MTOK = NBATCH * SEQ;
constexpr int INW = 2304, DFF = 2816, NGU = 2 * DFF;
constexpr int C_Q = 0, C_K = 512, C_V = 1024, C_U = 1536, C_VG = 1792, C_XC = 2048;
constexpr float EPS = 1e-6f;
constexpr int LDS_BYTES = 155648;

constexpr size_t MiB = 1u << 20;
constexpr size_t SZ_WIN = (size_t)INW * DM * 2, SZ_WOUT = (size_t)DM * DM * 2, SZ_WGU = (size_t)NGU * DM * 2, SZ_WDN = (size_t)DM * DFF * 2;
constexpr size_t WS_WIN = 0;
constexpr size_t WS_WOUT = 18 * MiB;
constexpr size_t WS_WGU = 26 * MiB;
constexpr size_t WS_WDN = 70 * MiB;
constexpr size_t WS_WSP = 92 * MiB;
constexpr size_t WS_T = 93 * MiB;
constexpr size_t WS_SSQ = 109 * MiB;
constexpr size_t WS_XB = 113 * MiB;
constexpr size_t WS_ABT = 241 * MiB;
constexpr size_t WS_PROJ = 305 * MiB;
constexpr size_t WS_MIX = 593 * MiB;
constexpr size_t WS_HID = WS_PROJ;
constexpr size_t WS_CTL = 721 * MiB;
constexpr size_t WS_END = 722 * MiB;
static_assert(4 * SZ_WIN <= 18 * MiB && 4 * SZ_WGU <= 44 * MiB && 4 * SZ_WDN <= 22 * MiB && (size_t)MTOK * DFF * 2 <= 416 * MiB, "ws map");

typedef __bf16 bf16v2 __attribute__((ext_vector_type(2)));
typedef float f32v2 __attribute__((ext_vector_type(2)));
__device__ __forceinline__ unsigned cvt_pk_bf16(float lo, float hi) { const f32v2 v = {lo, hi}; const bf16v2 b = __builtin_convertvector(v, bf16v2); return __builtin_bit_cast(unsigned, b); }
__device__ __forceinline__ float bf2f(unsigned h) { return __uint_as_float(h << 16); }
__device__ __forceinline__ float gelu_tanh(float x) { const float t = -2.3022082f * (x + 0.044715f * x * x * x); return x * __builtin_amdgcn_rcpf(1.0f + __builtin_amdgcn_exp2f(t)); }
__device__ __forceinline__ float silu_f(float x) { return x * __builtin_amdgcn_rcpf(1.0f + __builtin_amdgcn_exp2f(-1.44269504f * x)); }
__device__ __forceinline__ float wave_sum(float v) {
#pragma unroll
    for (int o = 1; o < 64; o <<= 1) v += __shfl_xor(v, o);
    return v;
}
typedef unsigned long long u64;
constexpr float RSS_SCALE = 16777216.0f;
__device__ __forceinline__ float row_rs(const u64* rss, int row) { return rsqrtf((float)rss[row] * (1.0f / (RSS_SCALE * 1024.0f)) + EPS); }
__device__ __forceinline__ void headnorm_store(f32x4 (&o)[4], bf16_t* dst) {
    float ss = 0.f;
#pragma unroll
    for (int dg = 0; dg < 4; ++dg) ss += (o[dg][0] * o[dg][0] + o[dg][1] * o[dg][1]) + (o[dg][2] * o[dg][2] + o[dg][3] * o[dg][3]);
    ss += __shfl_xor(ss, 16); ss += __shfl_xor(ss, 32);
    const float sc = rsqrtf(ss * (1.0f / 64.0f) + EPS);
#pragma unroll
    for (int dg = 0; dg < 4; ++dg) { u32x2 w; w.x = cvt_pk_bf16(o[dg][0] * sc, o[dg][1] * sc); w.y = cvt_pk_bf16(o[dg][2] * sc, o[dg][3] * sc); *(u32x2*)(dst + 16 * dg) = w; }
}

namespace pg8 {
constexpr int BM = 256, BK = 64, HALF = 128, HTB = HALF * BK * 2, STAGE_BYTES = 8 * HTB, NXCD = 8, WGM = 8;
__host__ __device__ __forceinline__ int lds_byte(int r, int c) { const int st = (r >> 4) * 2 + (c >> 5), rr = r & 15, cc = c & 31, ob = rr * 64 + cc * 2; return st * 1024 + (ob ^ (((ob >> 9) & 1) << 5)); }
__host__ __device__ __forceinline__ void stage_rc(int b, int& R, int& C) { const int st = b / 1024, sb = b % 1024, swz = sb ^ (((sb >> 9) & 1) << 5); R = (st >> 1) * 16 + swz / 64; C = (st & 1) * 32 + (swz % 64) / 2; }
__host__ __device__ __forceinline__ int perm32(int rho) { const int n = rho >> 4, i = rho & 15; return 8 * (i >> 2) + 4 * n + (i & 3); }

struct Unit { int pm, pn; };
struct Gemm { const bf16_t* A; const bf16_t* Bt; int M, N, K; };

struct StaticOrder {
    int nM, nN, nwg, G, c;
    __device__ void init(int M, int N, int G_, int c_) { nM = M / BM; nN = N / BM; nwg = nM * nN; G = G_; c = c_; }
    __device__ bool next(int i, Unit& u) const {
        const long L = (long)i * G + c; if (L >= nwg) return false;
        int wgid = (int)L; { const int q = nwg / NXCD, r = nwg % NXCD, xcd = wgid % NXCD, off = wgid / NXCD; wgid = (xcd < r ? xcd * (q + 1) : r * (q + 1) + (xcd - r) * q) + off; }
        const int nig = WGM * nN, gid = wgid / nig, fm = gid * WGM, gsz = (nM - fm) < WGM ? (nM - fm) : WGM;
        u.pm = fm + ((wgid % nig) % gsz); u.pn = (wgid % nig) / gsz; return true;
    }
    __device__ __forceinline__ void a_ready(const Unit&) const {}
    __device__ __forceinline__ void done(const Unit&) const {}
};
struct DftOrder {
    int G, c;
    __device__ void init(int G_, int c_) { G = G_; c = c_; }
    __device__ bool next(int i, Unit& u) const {
        const long L = (long)i * G + c; if (L >= 256) return false;
        const int x = (int)L & 7, j = (int)L >> 3; u.pm = j & 7; u.pn = x * 4 + (j >> 3); return true;
    }
    __device__ __forceinline__ void a_ready(const Unit&) const {}
    __device__ __forceinline__ void done(const Unit&) const {}
};

struct EpiProj {
    static constexpr bool PERM = true, AFTER_DRAIN = false;
    bf16_t* O; int ldc; const u64* ssq;
    __device__ __forceinline__ void operator()(const f32x4 (&acc)[2][2][4][2], const Unit& u, int wr, int wc, int fr, int fq) const {
        const int row0 = u.pm * BM + wr * 64 + fr, col0 = u.pn * BM + wc * 32 + 8 * fq;
        float rsv[2][4];
#pragma unroll
        for (int ai = 0; ai < 2; ++ai)
#pragma unroll
            for (int m = 0; m < 4; ++m) rsv[ai][m] = row_rs(ssq, row0 + ai * HALF + m * 16);
#pragma unroll
        for (int ai = 0; ai < 2; ++ai)
#pragma unroll
            for (int m = 0; m < 4; ++m) { const int row = row0 + ai * HALF + m * 16; const float rs = rsv[ai][m]; bf16_t* rowp = O + (size_t)row * ldc + col0;
#pragma unroll
                for (int bj = 0; bj < 2; ++bj) { const f32x4 v0 = acc[ai][bj][m][0] * rs, v1 = acc[ai][bj][m][1] * rs;
                    u32x4 w; w.x = cvt_pk_bf16(v0[0], v0[1]); w.y = cvt_pk_bf16(v0[2], v0[3]); w.z = cvt_pk_bf16(v1[0], v1[1]); w.w = cvt_pk_bf16(v1[2], v1[3]);
                    *(u32x4*)(rowp + bj * HALF) = w; } }
    }
};
struct EpiGU {
    static constexpr bool PERM = true, AFTER_DRAIN = false;
    bf16_t* O; const u64* ssq;
    __device__ __forceinline__ void operator()(const f32x4 (&acc)[2][2][4][2], const Unit& u, int wr, int wc, int fr, int fq) const {
        const int row0 = u.pm * BM + wr * 64 + fr, col0 = u.pn * HALF + wc * 32 + 8 * fq;
        float rsv[2][4];
#pragma unroll
        for (int ai = 0; ai < 2; ++ai)
#pragma unroll
            for (int m = 0; m < 4; ++m) rsv[ai][m] = row_rs(ssq, row0 + ai * HALF + m * 16);
#pragma unroll
        for (int ai = 0; ai < 2; ++ai)
#pragma unroll
            for (int m = 0; m < 4; ++m) { const int row = row0 + ai * HALF + m * 16; const float rs = rsv[ai][m];
                f32x4 h[2];
#pragma unroll
                for (int n = 0; n < 2; ++n) { const f32x4 g = acc[ai][0][m][n] * rs, up = acc[ai][1][m][n] * rs;
#pragma unroll
                    for (int e = 0; e < 4; ++e) h[n][e] = silu_f(g[e]) * up[e]; }
                u32x4 w; w.x = cvt_pk_bf16(h[0][0], h[0][1]); w.y = cvt_pk_bf16(h[0][2], h[0][3]); w.z = cvt_pk_bf16(h[1][0], h[1][1]); w.w = cvt_pk_bf16(h[1][2], h[1][3]);
                *(u32x4*)(O + (size_t)row * DFF + col0) = w; }
    }
};
struct EpiRes {
    static constexpr bool PERM = true, AFTER_DRAIN = false;
    bf16_t* xb; u64* ssq;
    __device__ __forceinline__ void operator()(const f32x4 (&acc)[2][2][4][2], const Unit& u, int wr, int wc, int fr, int fq) const {
        const int row0 = u.pm * BM + wr * 64 + fr, col0 = u.pn * BM + wc * 32 + 8 * fq;
        u32x4 bb[2][2];
#define RES_LOAD(idx) do { const size_t off_ = (size_t)(row0 + ((idx) >> 2) * HALF + ((idx) & 3) * 16) * DM + col0; \
            bb[(idx) & 1][0] = *(const u32x4*)(xb + off_); bb[(idx) & 1][1] = *(const u32x4*)(xb + off_ + HALF); } while (0)
        RES_LOAD(0);
        asm volatile("" ::: "memory");
#pragma unroll
        for (int idx = 0; idx < 8; ++idx) { const int ai = idx >> 2, m = idx & 3; const int row = row0 + ai * HALF + m * 16; const size_t off = (size_t)row * DM + col0; float ss = 0.f;
            if (idx < 7) RES_LOAD(idx + 1);
#pragma unroll
            for (int bj = 0; bj < 2; ++bj) { const u32x4 b = bb[idx & 1][bj];
                const f32x4 r0 = (f32x4){bf2f(b.x & 0xffffu), bf2f(b.x >> 16), bf2f(b.y & 0xffffu), bf2f(b.y >> 16)}, r1 = (f32x4){bf2f(b.z & 0xffffu), bf2f(b.z >> 16), bf2f(b.w & 0xffffu), bf2f(b.w >> 16)};
                const f32x4 v0 = r0 + acc[ai][bj][m][0], v1 = r1 + acc[ai][bj][m][1];
                u32x4 w; w.x = cvt_pk_bf16(v0[0], v0[1]); w.y = cvt_pk_bf16(v0[2], v0[3]); w.z = cvt_pk_bf16(v1[0], v1[1]); w.w = cvt_pk_bf16(v1[2], v1[3]);
                *(u32x4*)(xb + off + bj * HALF) = w;
                ss += (v0[0] * v0[0] + v0[1] * v0[1]) + (v0[2] * v0[2] + v0[3] * v0[3]) + (v1[0] * v1[0] + v1[1] * v1[1]) + (v1[2] * v1[2] + v1[3] * v1[3]); }
            ss += __shfl_xor(ss, 16); ss += __shfl_xor(ss, 32);
            if (fq == 0) (void)__hip_atomic_fetch_add(ssq + row, (u64)(ss * RSS_SCALE), __ATOMIC_RELAXED, __HIP_MEMORY_SCOPE_AGENT);
            asm volatile("" ::: "memory"); }
#undef RES_LOAD
    }
};
struct EpiDft {
    static constexpr bool PERM = true, AFTER_DRAIN = false;
    bf16_t* mix; const float* ah;
    __device__ __forceinline__ void operator()(const f32x4 (&acc)[2][2][4][2], const Unit& u, int wr, int wc, int fr, int fq) const {
        const int row0 = u.pn * SEQ + u.pm * BM + wr * 64 + fr;
        const float sg = (fr & 1) ? -0.022097086912f : 0.022097086912f;
        f32x4 hv[2][2];
#pragma unroll
        for (int bj = 0; bj < 2; ++bj)
#pragma unroll
            for (int n = 0; n < 2; ++n) hv[bj][n] = *(const f32x4*)(ah + u.pn * 256 + 128 * bj + 32 * wc + 8 * fq + 4 * n) * sg;
#pragma unroll
        for (int ai = 0; ai < 2; ++ai)
#pragma unroll
            for (int m = 0; m < 4; ++m) { const int row = row0 + ai * HALF + m * 16; float ss = 0.f; f32x4 v[2][2];
#pragma unroll
                for (int bj = 0; bj < 2; ++bj)
#pragma unroll
                    for (int n = 0; n < 2; ++n) { v[bj][n] = acc[ai][bj][m][n] + hv[bj][n]; ss += (v[bj][n][0] * v[bj][n][0] + v[bj][n][1] * v[bj][n][1]) + (v[bj][n][2] * v[bj][n][2] + v[bj][n][3] * v[bj][n][3]); }
                ss += __shfl_xor(ss, 16); ss += __shfl_xor(ss, 32);
                const float sc = rsqrtf(ss * (1.0f / 64.0f) + EPS);
                bf16_t* rowp = mix + (size_t)row * DM + 768 + 64 * wc + 8 * fq;
#pragma unroll
                for (int bj = 0; bj < 2; ++bj) { const f32x4 v0 = v[bj][0] * sc, v1 = v[bj][1] * sc;
                    u32x4 w; w.x = cvt_pk_bf16(v0[0], v0[1]); w.y = cvt_pk_bf16(v0[2], v0[3]); w.z = cvt_pk_bf16(v1[0], v1[1]); w.w = cvt_pk_bf16(v1[2], v1[3]);
                    *(u32x4*)(rowp + 32 * bj) = w; }
                asm volatile("" ::: "memory"); }
    }
};

template <class Epi, class Sched, bool ALIGN_EPI = false, bool SP2 = false>
__device__ __forceinline__ void gemm_phase(LAS unsigned char* lds, const Gemm g, const Sched& S, const Epi& E) {
    int tid_ = threadIdx.x; asm volatile("" : "+v"(tid_));
    const int tid = tid_, wid = __builtin_amdgcn_readfirstlane(tid >> 6), lane = tid & 63, wr = wid >> 2, wc = wid & 3, fr = lane & 15, fq = lane >> 4;
    const int K = g.K, nt = K / BK;
    unsigned voffA[2], voffB[2];
#pragma unroll
    for (int i = 0; i < 2; ++i) { int R, C; stage_rc(tid * 16 + i * 8192, R, C); const int Rb = Epi::PERM ? ((R & ~31) + perm32(R & 31)) : R;
        voffA[i] = (unsigned)(R * K + C) * 2u; voffB[i] = (unsigned)(Rb * K + C) * 2u; }
    const size_t kstep = (size_t)(BK * 2);
    const size_t hstep = (size_t)HALF * K * 2;
    const size_t tstep = 2 * hstep;
    const unsigned ldsw = (unsigned)wid * 1024u;
    const int aoff = lds_byte(wr * 64 + fr, fq * 8), boff = lds_byte(wc * 32 + fr, fq * 8);
#define PG8_SA(b, h) (((b) * 2 + (h)) * HTB)
#define PG8_SB(b, h) ((4 + (b) * 2 + (h)) * HTB)
#define PG8_STAGE(bufoff, gbase, voff) do { _Pragma("unroll") for (int _i = 0; _i < 2; ++_i) \
        __builtin_amdgcn_global_load_lds((const unsigned*)((const char*)(gbase) + (voff)[_i]), (LAS unsigned*)(lds + (bufoff) + ldsw + _i * 8192), 16, 0, 0); } while (0)
#define PG8_LDA(dst, b, h) do { _Pragma("unroll") for (int m = 0; m < 4; ++m) _Pragma("unroll") for (int k = 0; k < 2; ++k) dst[m][k] = *(const LAS bf16x8*)(lds + PG8_SA(b, h) + aoff + m * 2048 + k * 1024); } while (0)
#define PG8_LDB(dst, b, h) do { _Pragma("unroll") for (int n = 0; n < 2; ++n) _Pragma("unroll") for (int k = 0; k < 2; ++k) dst[n][k] = *(const LAS bf16x8*)(lds + PG8_SB(b, h) + boff + n * 2048 + k * 1024); } while (0)
#define PG8_MMA(ai, bj, At, Bt) do { __builtin_amdgcn_s_setprio(1); _Pragma("unroll") for (int m = 0; m < 4; ++m) _Pragma("unroll") for (int n = 0; n < 2; ++n) _Pragma("unroll") for (int k = 0; k < 2; ++k) \
        acc[ai][bj][m][n] = __builtin_amdgcn_mfma_f32_16x16x32_bf16(Bt[n][k], At[m][k], acc[ai][bj][m][n], 0, 0, 0); __builtin_amdgcn_s_setprio(0); } while (0)
#define PG8_WAIT_V(n) asm volatile("s_waitcnt vmcnt(" #n ")" ::: "memory")
#define PG8_WAIT_L(n) asm volatile("s_waitcnt lgkmcnt(" #n ")" ::: "memory")
#define PG8_BAR __builtin_amdgcn_s_barrier()
#define PG8_SCHED __builtin_amdgcn_sched_barrier(0)
    Unit cur, nxt; int ui = 0;
    if (!S.next(0, cur)) return;
    f32x4 acc[2][2][4][2];
#pragma unroll
    for (int a = 0; a < 2; ++a)
#pragma unroll
        for (int b = 0; b < 2; ++b)
#pragma unroll
            for (int m = 0; m < 4; ++m)
#pragma unroll
                for (int n = 0; n < 2; ++n) acc[a][b][m][n] = (f32x4){0.f, 0.f, 0.f, 0.f};
    bf16x8 At[4][2], B0[2][2], B1[2][2];
    const char* cA = (const char*)g.A + (size_t)cur.pm * tstep; const char* cB = (const char*)g.Bt + (size_t)cur.pn * tstep;
    S.a_ready(cur);
    if constexpr (SP2) {
        PG8_STAGE(PG8_SB(0, 0), cB, voffB); PG8_STAGE(PG8_SB(0, 1), cB + hstep, voffB); PG8_STAGE(PG8_SA(0, 0), cA, voffA); PG8_STAGE(PG8_SA(0, 1), cA + hstep, voffA);
        if (wr == 1) PG8_BAR;
        PG8_WAIT_V(2); PG8_BAR;
        PG8_STAGE(PG8_SB(1, 0), cB + kstep, voffB); PG8_STAGE(PG8_SA(1, 0), cA + kstep, voffA); PG8_STAGE(PG8_SB(1, 1), cB + hstep + kstep, voffB);
        PG8_WAIT_V(6); PG8_BAR;
    } else {
        PG8_STAGE(PG8_SB(0, 0), cB, voffB); PG8_STAGE(PG8_SA(0, 0), cA, voffA); PG8_STAGE(PG8_SB(0, 1), cB + hstep, voffB); PG8_STAGE(PG8_SA(0, 1), cA + hstep, voffA);
        if (wr == 1) PG8_BAR;
        PG8_WAIT_V(4); PG8_BAR;
        PG8_STAGE(PG8_SB(1, 0), cB + kstep, voffB); PG8_STAGE(PG8_SA(1, 0), cA + kstep, voffA); PG8_STAGE(PG8_SB(1, 1), cB + hstep + kstep, voffB);
        PG8_WAIT_V(6); PG8_BAR;
    }
    for (;;) {
        const bool has_next = S.next(ui + 1, nxt);
        const char* nA = has_next ? (const char*)g.A + (size_t)nxt.pm * tstep : cA; const char* nB = has_next ? (const char*)g.Bt + (size_t)nxt.pn * tstep : cB;
        for (int t = 0; t < nt; t += 2) {
            const bool last = (t == nt - 2);
            const char* a1 = cA + (size_t)(t + 1) * kstep;
            const char* a2 = last ? nA : cA + (size_t)(t + 2) * kstep; const char* b2 = last ? nB : cB + (size_t)(t + 2) * kstep;
            const char* a3 = a2 + kstep; const char* b3 = b2 + kstep;
            if (last && has_next) S.a_ready(nxt);
            if constexpr (SP2) {
            PG8_LDB(B0, 0, 0); PG8_LDB(B1, 0, 1); PG8_SCHED; PG8_LDA(At, 0, 0); PG8_STAGE(PG8_SA(1, 1), a1 + hstep, voffA);
            PG8_WAIT_V(8); PG8_WAIT_L(0); PG8_BAR; PG8_MMA(0, 0, At, B0); PG8_MMA(0, 1, At, B1); PG8_BAR; PG8_SCHED;
            PG8_LDA(At, 0, 1); PG8_STAGE(PG8_SB(0, 0), b2, voffB); PG8_STAGE(PG8_SB(0, 1), b2 + hstep, voffB); PG8_STAGE(PG8_SA(0, 0), a2, voffA);
            PG8_WAIT_V(8); PG8_WAIT_L(0); PG8_BAR; PG8_MMA(1, 0, At, B0); PG8_MMA(1, 1, At, B1); PG8_BAR; PG8_SCHED;
            PG8_LDB(B0, 1, 0); PG8_LDB(B1, 1, 1); PG8_SCHED; PG8_LDA(At, 1, 0); PG8_STAGE(PG8_SA(0, 1), a2 + hstep, voffA);
            PG8_WAIT_V(8); PG8_WAIT_L(0); PG8_BAR; PG8_MMA(0, 0, At, B0); PG8_MMA(0, 1, At, B1); PG8_BAR; PG8_SCHED;
            PG8_LDA(At, 1, 1); PG8_STAGE(PG8_SB(1, 0), b3, voffB); PG8_STAGE(PG8_SB(1, 1), b3 + hstep, voffB); PG8_STAGE(PG8_SA(1, 0), a3, voffA);
            PG8_WAIT_V(8); PG8_WAIT_L(0); PG8_BAR; PG8_MMA(1, 0, At, B0); PG8_MMA(1, 1, At, B1); PG8_BAR; PG8_SCHED;
            } else {
            PG8_LDB(B0, 0, 0); PG8_SCHED; PG8_LDA(At, 0, 0); PG8_STAGE(PG8_SA(1, 1), a1 + hstep, voffA);
            PG8_WAIT_L(8); PG8_BAR; PG8_WAIT_L(0); PG8_MMA(0, 0, At, B0); PG8_BAR; PG8_SCHED;
            PG8_LDB(B1, 0, 1); PG8_STAGE(PG8_SB(0, 0), b2, voffB);
            PG8_BAR; PG8_WAIT_L(0); PG8_MMA(0, 1, At, B1); PG8_BAR;
            PG8_LDA(At, 0, 1); PG8_STAGE(PG8_SA(0, 0), a2, voffA);
            PG8_BAR; PG8_WAIT_L(0); PG8_MMA(1, 0, At, B0); PG8_BAR; PG8_SCHED;
            PG8_STAGE(PG8_SB(0, 1), b2 + hstep, voffB);
            PG8_WAIT_V(6); PG8_BAR; PG8_MMA(1, 1, At, B1); PG8_BAR;
            PG8_LDB(B0, 1, 0); PG8_SCHED; PG8_LDA(At, 1, 0); PG8_STAGE(PG8_SA(0, 1), a2 + hstep, voffA);
            PG8_WAIT_L(8); PG8_BAR; PG8_WAIT_L(0); PG8_MMA(0, 0, At, B0); PG8_BAR; PG8_SCHED;
            PG8_LDB(B1, 1, 1); PG8_STAGE(PG8_SB(1, 0), b3, voffB);
            PG8_BAR; PG8_WAIT_L(0); PG8_MMA(0, 1, At, B1); PG8_BAR;
            PG8_LDA(At, 1, 1); PG8_STAGE(PG8_SA(1, 0), a3, voffA);
            PG8_BAR; PG8_WAIT_L(0); PG8_MMA(1, 0, At, B0); PG8_BAR; PG8_SCHED;
            PG8_STAGE(PG8_SB(1, 1), b3 + hstep, voffB);
            PG8_WAIT_V(6); PG8_BAR; PG8_MMA(1, 1, At, B1); PG8_BAR;
            }
        }
        if constexpr (ALIGN_EPI) { if (wr == 0) PG8_BAR; }
        if constexpr (!Epi::AFTER_DRAIN) { E(acc, cur, wr, wc, fr, fq); S.done(cur); }
        if (!has_next) break;
#pragma unroll
        for (int a = 0; a < 2; ++a)
#pragma unroll
            for (int b = 0; b < 2; ++b)
#pragma unroll
                for (int m = 0; m < 4; ++m)
#pragma unroll
                    for (int n = 0; n < 2; ++n) acc[a][b][m][n] = (f32x4){0.f, 0.f, 0.f, 0.f};
        cur = nxt; cA = nA; cB = nB; ++ui;
        if constexpr (ALIGN_EPI) { if (wr == 1) PG8_BAR; }
    }
    PG8_WAIT_V(0);
    if constexpr (!ALIGN_EPI) { if (wr == 0) PG8_BAR; }
    PG8_BAR;
#undef PG8_SA
#undef PG8_SB
#undef PG8_STAGE
#undef PG8_LDA
#undef PG8_LDB
#undef PG8_MMA
#undef PG8_WAIT_V
#undef PG8_WAIT_L
#undef PG8_BAR
#undef PG8_SCHED
}
}

__device__ __forceinline__ void transpose_item(const float* W, int K, int N, bf16_t* WT, int drow0, const float* gk, float cs, LAS float* scr, int kb, int nb, int lane) {
    const int k0 = 64 * kb, n0 = 32 * nb;
#pragma unroll
    for (int i = 0; i < 32; ++i) { const int kk = 2 * i + (lane >> 5); const float gsc = gk ? gk[k0 + kk] * cs : cs; scr[kk * 33 + (lane & 31)] = W[(size_t)(k0 + kk) * N + n0 + (lane & 31)] * gsc; }
    asm volatile("s_waitcnt lgkmcnt(0)" ::: "memory");
    const int c = lane & 7;
#pragma unroll
    for (int j = 0; j < 4; ++j) { const int n = (lane >> 3) + 8 * j; const LAS float* s = scr + (8 * c) * 33 + n;
        u32x4 o; o.x = cvt_pk_bf16(s[0 * 33], s[1 * 33]); o.y = cvt_pk_bf16(s[2 * 33], s[3 * 33]); o.z = cvt_pk_bf16(s[4 * 33], s[5 * 33]); o.w = cvt_pk_bf16(s[6 * 33], s[7 * 33]);
        *(u32x4*)(WT + (size_t)(drow0 + n) * K + k0 + 8 * c) = o; }
    asm volatile("s_waitcnt lgkmcnt(0)" ::: "memory");
}

struct Args { const float* in[15]; float* out; unsigned char* ws; };

__device__ __forceinline__ void attn_item(LAS unsigned char* lds, const bf16_t* PROJ, bf16_t* MIX, const float* rpb_l, int item, int tid, int wid, int lane) {
    const int b = item >> 3, h = item & 7, fr = lane & 15, fq = lane >> 4;
    LAS unsigned char* Kl = lds; LAS unsigned char* Vl = lds + 73728; LAS float* bias = (LAS float*)(lds + 147456);
    for (int i = tid; i < 480; i += 512) { const int dr_ = i >> 5, dc_ = i & 31; bias[i] = dc_ < 31 ? rpb_l[h * 465 + dr_ * 31 + dc_] * 1.44269504f : -INFINITY; }
    const bf16_t* base = PROJ + (size_t)b * SEQ * INW + h * 64;
    const int lkey = tid >> 2, lcp = tid & 3, lrow = lkey >> 6, lkc = lkey & 63;
    u32x4 kreg0, kreg1, vreg0, vreg1;
    kreg0 = kreg1 = vreg0 = vreg1 = (u32x4){0u, 0u, 0u, 0u};
#define ATT_LOAD(row_lo, cnt) do { if (lrow < (cnt)) { const bf16_t* p_ = base + (size_t)(((row_lo) + lrow) * 64 + lkc) * INW + C_K + lcp * 16; \
        kreg0 = *(const u32x4*)p_; kreg1 = *(const u32x4*)(p_ + 8); vreg0 = *(const u32x4*)(p_ + 512); vreg1 = *(const u32x4*)(p_ + 520); } } while (0)
#define ATT_STORE(row_lo, cnt) do { if (lrow < (cnt)) { const int slot_ = ((row_lo) + lrow) % 9; const int sw_ = (lkc >> 1) & 7; \
        LAS unsigned char* kp_ = Kl + slot_ * 8192 + lkc * 128; \
        *(LAS u32x4*)(kp_ + (((2 * lcp) ^ sw_) << 4)) = kreg0; *(LAS u32x4*)(kp_ + (((2 * lcp + 1) ^ sw_) << 4)) = kreg1; \
        LAS unsigned char* vp_ = Vl + slot_ * 8192 + (lkc & 3) * 2; const int c8_ = lkc >> 2; \
        _Pragma("unroll") for (int e_ = 0; e_ < 8; ++e_) { const int d0_ = lcp * 16 + e_, d1_ = d0_ + 8; \
            const unsigned x0_ = (vreg0[e_ >> 1] >> (16 * (e_ & 1))) & 0xffffu, x1_ = (vreg1[e_ >> 1] >> (16 * (e_ & 1))) & 0xffffu; \
            *(LAS unsigned short*)(vp_ + d0_ * 128 + ((c8_ ^ (((d0_ >> 1) & 7) << 1)) << 3)) = (unsigned short)x0_; \
            *(LAS unsigned short*)(vp_ + d1_ * 128 + ((c8_ ^ (((d1_ >> 1) & 7) << 1)) << 3)) = (unsigned short)x1_; } } } while (0)
    for (int q = 0; q < 4; ++q) { ATT_LOAD(2 * q, 2); ATT_STORE(2 * q, 2); }
    int loaded = 8;
    __syncthreads();
    const int j = wid & 3, bs = min(max(16 * j - 8, 0), 32), qc = 16 * j + fr, wsq = min(max(qc - 8, 0), 48);
    const bf16_t* qbase = PROJ + ((size_t)b * SEQ + (wid >> 2) * 64 + qc) * INW + C_Q + h * 64 + fq * 8;
    bf16x8 bq0 = *(const bf16x8*)qbase, bq1 = *(const bf16x8*)(qbase + 32);
    int boff[8];
#pragma unroll
    for (int k = 0; k < 8; ++k) { const int kc = bs + 16 * (k >> 2) + 4 * fq + (k & 3); const bool inw = (kc >= wsq) && (kc < wsq + 16); boff[k] = (inw ? (kc - qc + 15) : 31) * 4; }
#pragma unroll 1
    for (int s = 0; s < 16; ++s) {
        const int need_next = (s < 15) ? (min(max(2 * (s + 1) - 3, 0), 24) + 8) : loaded;
        const int cnt = need_next - loaded;
        ATT_LOAD(loaded, cnt);
        {
            const int r = 2 * s + (wid >> 2), rs = min(max(r - 4, 0), 24);
            const size_t qtok = (size_t)b * SEQ + r * 64 + qc;
            const bf16_t* qn = qbase + (size_t)(s < 15 ? s + 1 : s) * 128 * INW;
            const bf16x8 bqn0 = *(const bf16x8*)qn, bqn1 = *(const bf16x8*)(qn + 32);
            f32x4 S[16];
            int slot = rs % 9;
            const int slot0 = slot;
#pragma unroll
            for (int i = 0; i < 8; ++i) {
#pragma unroll
                for (int hf = 0; hf < 2; ++hf) {
                    const int kc = bs + 16 * hf + fr, sw = (kc >> 1) & 7;
                    const LAS unsigned char* kp = Kl + slot * 8192 + kc * 128;
                    const bf16x8 a0 = *(const LAS bf16x8*)(kp + ((fq ^ sw) << 4)), a1 = *(const LAS bf16x8*)(kp + (((fq + 4) ^ sw) << 4));
                    f32x4 acc = (f32x4){0.f, 0.f, 0.f, 0.f};
                    acc = __builtin_amdgcn_mfma_f32_16x16x32_bf16(a0, bq0, acc, 0, 0, 0);
                    acc = __builtin_amdgcn_mfma_f32_16x16x32_bf16(a1, bq1, acc, 0, 0, 0);
                    S[2 * i + hf] = acc;
                }
                slot = (slot == 8) ? 0 : slot + 1;
            }
            float mx = -INFINITY;
            const LAS unsigned char* brow = (const LAS unsigned char*)bias + (rs - r + 7) * 128;
#pragma unroll
            for (int i = 0; i < 8; ++i)
#pragma unroll
                for (int k = 0; k < 8; ++k) { const float v = S[2 * i + (k >> 2)][k & 3] + *(const LAS float*)(brow + i * 128 + boff[k]); S[2 * i + (k >> 2)][k & 3] = v; mx = fmaxf(mx, v); }
            mx = fmaxf(mx, __shfl_xor(mx, 16)); mx = fmaxf(mx, __shfl_xor(mx, 32));
            float l = 0.f;
#pragma unroll
            for (int g = 0; g < 16; ++g)
#pragma unroll
                for (int e = 0; e < 4; ++e) { const float p = __builtin_amdgcn_exp2f(S[g][e] - mx); S[g][e] = p; l += p; }
            l += __shfl_xor(l, 16); l += __shfl_xor(l, 32);
            f32x4 o[4];
#pragma unroll
            for (int dg = 0; dg < 4; ++dg) o[dg] = (f32x4){0.f, 0.f, 0.f, 0.f};
            slot = slot0;
#pragma unroll
            for (int i = 0; i < 8; ++i) {
                u32x4 pw; pw.x = cvt_pk_bf16(S[2 * i][0], S[2 * i][1]); pw.y = cvt_pk_bf16(S[2 * i][2], S[2 * i][3]); pw.z = cvt_pk_bf16(S[2 * i + 1][0], S[2 * i + 1][1]); pw.w = cvt_pk_bf16(S[2 * i + 1][2], S[2 * i + 1][3]);
                const bf16x8 pb = __builtin_bit_cast(bf16x8, pw);
#pragma unroll
                for (int dg = 0; dg < 4; ++dg) { const int d = 16 * dg + fr, swv = ((d >> 1) & 7) << 1, cA = (bs >> 2) + fq, cB = cA + 4;
                    const LAS unsigned char* vp = Vl + slot * 8192 + d * 128;
                    const u32x2 lo = *(const LAS u32x2*)(vp + ((cA ^ swv) << 3)), hi = *(const LAS u32x2*)(vp + ((cB ^ swv) << 3));
                    const u32x4 aw = (u32x4){lo.x, lo.y, hi.x, hi.y};
                    o[dg] = __builtin_amdgcn_mfma_f32_16x16x32_bf16(__builtin_bit_cast(bf16x8, aw), pb, o[dg], 0, 0, 0); }
                slot = (slot == 8) ? 0 : slot + 1;
            }
            const float inv = __builtin_amdgcn_rcpf(l);
#pragma unroll
            for (int dg = 0; dg < 4; ++dg) o[dg] = o[dg] * inv;
            headnorm_store(o, MIX + qtok * DM + h * 64 + 4 * fq);
            bq0 = bqn0; bq1 = bqn1;
        }
        __syncthreads();
        ATT_STORE(loaded, cnt); loaded += cnt;
        __syncthreads();
    }
#undef ATT_LOAD
#undef ATT_STORE
}

__device__ __forceinline__ void gate_item(LAS unsigned char* lds, const bf16_t* PROJ, bf16_t* MIX, const float* lng, const float* lnb, const bf16_t* wsb, const float* bsp, int item, int wid, int lane) {
    const int fr = lane & 15, fq = lane >> 4;
    const size_t tok0 = (size_t)item * 128;
    constexpr int PITCH = 272;
    float g4[4], b4[4];
#pragma unroll
    for (int i = 0; i < 4; ++i) { g4[i] = lng[lane + 64 * i]; b4[i] = lnb[lane + 64 * i]; }
#pragma unroll 1
    for (int t0 = 0; t0 < 16; t0 += 4) {
        float v[4][4], s[4], s2[4];
#pragma unroll
        for (int uu = 0; uu < 4; ++uu) { const bf16_t* zp = PROJ + (tok0 + 16 * wid + t0 + uu) * INW + C_VG;
#pragma unroll
            for (int i = 0; i < 4; ++i) v[uu][i] = bf2f(zp[lane + 64 * i]); }
#pragma unroll
        for (int uu = 0; uu < 4; ++uu) { s[uu] = 0.f;
#pragma unroll
            for (int i = 0; i < 4; ++i) { v[uu][i] = gelu_tanh(v[uu][i]); s[uu] += v[uu][i]; } }
#pragma unroll
        for (int o = 1; o < 64; o <<= 1)
#pragma unroll
            for (int uu = 0; uu < 4; ++uu) s[uu] += __shfl_xor(s[uu], o);
#pragma unroll
        for (int uu = 0; uu < 4; ++uu) { const float mean = s[uu] * (1.0f / 256.0f); s2[uu] = 0.f;
#pragma unroll
            for (int i = 0; i < 4; ++i) { v[uu][i] -= mean; s2[uu] += v[uu][i] * v[uu][i]; } }
#pragma unroll
        for (int o = 1; o < 64; o <<= 1)
#pragma unroll
            for (int uu = 0; uu < 4; ++uu) s2[uu] += __shfl_xor(s2[uu], o);
#pragma unroll
        for (int uu = 0; uu < 4; ++uu) { const float rstd = rsqrtf(s2[uu] * (1.0f / 256.0f) + EPS); const int q = 16 * wid + t0 + uu;
#pragma unroll
            for (int i = 0; i < 4; ++i) { const float y = v[uu][i] * rstd * g4[i] + b4[i]; *(LAS unsigned short*)(lds + (lane + 64 * i) * PITCH + q * 2) = (unsigned short)(cvt_pk_bf16(y, 0.f) & 0xffffu); } }
    }
    __syncthreads();
    const int hh = wid >> 1, ph = wid & 1;
#pragma unroll 2
    for (int pt4 = 0; pt4 < 4; ++pt4) { const int p = 16 * (4 * ph + pt4) + fr;
        bf16x8 B[4];
#pragma unroll
        for (int ks = 0; ks < 4; ++ks) B[ks] = *(const bf16x8*)(wsb + (size_t)(hh * 128 + p) * 128 + 32 * ks + 8 * fq);
        f32x4 o[4];
#pragma unroll
        for (int dg = 0; dg < 4; ++dg) { f32x4 acc = (f32x4){0.f, 0.f, 0.f, 0.f};
#pragma unroll
            for (int ks = 0; ks < 4; ++ks) { const bf16x8 A = *(const LAS bf16x8*)(lds + (64 * hh + 16 * dg + fr) * PITCH + (32 * ks + 8 * fq) * 2); acc = __builtin_amdgcn_mfma_f32_16x16x32_bf16(A, B[ks], acc, 0, 0, 0); }
            o[dg] = acc; }
        const size_t tok = tok0 + (16 * (4 * ph + pt4)) + (lane >> 4) * 0 + 0;
        const size_t mytok = tok + fr;
        const float bsv = bsp[hh * 128 + p];
        const bf16_t* up = PROJ + mytok * INW + C_U + 64 * hh + 4 * fq;
#pragma unroll
        for (int dg = 0; dg < 4; ++dg) { const u32x2 uw = *(const u32x2*)(up + 16 * dg);
            const float u0 = gelu_tanh(bf2f(uw.x & 0xffffu)), u1 = gelu_tanh(bf2f(uw.x >> 16)), u2 = gelu_tanh(bf2f(uw.y & 0xffffu)), u3 = gelu_tanh(bf2f(uw.y >> 16));
            o[dg][0] = u0 * (o[dg][0] + bsv); o[dg][1] = u1 * (o[dg][1] + bsv); o[dg][2] = u2 * (o[dg][2] + bsv); o[dg][3] = u3 * (o[dg][3] + bsv); }
        headnorm_store(o, MIX + mytok * DM + 512 + 64 * hh + 4 * fq);
    }
    __syncthreads();
}

__device__ __forceinline__ void addsub_bf16x2(unsigned a, unsigned m, float msk, unsigned& e, unsigned& o) {
    const float al = bf2f(a & 0xffffu), ah = __uint_as_float(a & 0xffff0000u), ml = bf2f(m & 0xffffu), mh = __uint_as_float(m & 0xffff0000u);
    e = cvt_pk_bf16(al + msk * ml, ah + msk * mh); o = cvt_pk_bf16(al - ml, ah - mh);
}
__device__ __forceinline__ void chan_dft(LAS unsigned char* lds, const bf16_t* PROJ, bf16_t* ABT, float* AH, int tid, int gw, int ngw, int lane) {
    const int fr = lane & 15, fq = lane >> 4;
    LAS bf16_t* Ct = (LAS bf16_t*)lds; LAS bf16_t* St = (LAS bf16_t*)(lds + 9216);
    for (int idx = tid; idx < 4096; idx += 512) { const int cp = idx >> 6, c = idx & 63; const float ph = (float)((cp * c) & 63) * (1.0f / 32.0f);
        Ct[cp * 72 + c] = (bf16_t)(cvt_pk_bf16(cospif(ph) * 0.125f, 0.f) & 0xffffu); St[cp * 72 + c] = (bf16_t)(cvt_pk_bf16(sinpif(ph) * 0.125f, 0.f) & 0xffffu); }
    __syncthreads();
#pragma unroll 1
    for (int it = gw; it < NBATCH * 64; it += ngw) { const int b = it >> 6, n0 = (it & 63) * 16; const int np = n0 + fr, mp = (SEQ - np) & (SEQ - 1);
        const float msk = (np == 0) ? 0.f : 1.f; const size_t tokb = (size_t)b * SEQ;
#pragma unroll
        for (int gi = 0; gi < 4; ++gi) {
            const bf16_t* xn = PROJ + (tokb + np) * INW + C_XC + 64 * gi + 8 * fq; const bf16_t* xm = PROJ + (tokb + mp) * INW + C_XC + 64 * gi + 8 * fq;
            const u32x4 a0 = *(const u32x4*)xn, a1 = *(const u32x4*)(xn + 32), m0 = *(const u32x4*)xm, m1 = *(const u32x4*)(xm + 32);
            unsigned ev[8], ov[8];
            addsub_bf16x2(a0.x, m0.x, msk, ev[0], ov[0]); addsub_bf16x2(a0.y, m0.y, msk, ev[1], ov[1]); addsub_bf16x2(a0.z, m0.z, msk, ev[2], ov[2]); addsub_bf16x2(a0.w, m0.w, msk, ev[3], ov[3]);
            addsub_bf16x2(a1.x, m1.x, msk, ev[4], ov[4]); addsub_bf16x2(a1.y, m1.y, msk, ev[5], ov[5]); addsub_bf16x2(a1.z, m1.z, msk, ev[6], ov[6]); addsub_bf16x2(a1.w, m1.w, msk, ev[7], ov[7]);
            const u32x4 e0 = (u32x4){ev[0], ev[1], ev[2], ev[3]}, e1 = (u32x4){ev[4], ev[5], ev[6], ev[7]}, o0 = (u32x4){ov[0], ov[1], ov[2], ov[3]}, o1 = (u32x4){ov[4], ov[5], ov[6], ov[7]};
            const bf16x8 E0 = __builtin_bit_cast(bf16x8, e0), E1 = __builtin_bit_cast(bf16x8, e1), O0 = __builtin_bit_cast(bf16x8, o0), O1 = __builtin_bit_cast(bf16x8, o1);
#pragma unroll
            for (int ct = 0; ct < 4; ++ct) { const int cc = 16 * ct + fr;
                const bf16x8 Bc0 = *(const LAS bf16x8*)(Ct + cc * 72 + 8 * fq), Bc1 = *(const LAS bf16x8*)(Ct + cc * 72 + 32 + 8 * fq);
                const bf16x8 Bs0 = *(const LAS bf16x8*)(St + cc * 72 + 8 * fq), Bs1 = *(const LAS bf16x8*)(St + cc * 72 + 32 + 8 * fq);
                f32x4 aC = (f32x4){0.f, 0.f, 0.f, 0.f}, aS = (f32x4){0.f, 0.f, 0.f, 0.f};
                aC = __builtin_amdgcn_mfma_f32_16x16x32_bf16(E0, Bc0, aC, 0, 0, 0); aC = __builtin_amdgcn_mfma_f32_16x16x32_bf16(E1, Bc1, aC, 0, 0, 0);
                aS = __builtin_amdgcn_mfma_f32_16x16x32_bf16(O0, Bs0, aS, 0, 0, 0); aS = __builtin_amdgcn_mfma_f32_16x16x32_bf16(O1, Bs1, aS, 0, 0, 0);
                const int rho = 128 * (cc >> 5) + 32 * gi + (cc & 31);
                bf16_t* dst = ABT + ((size_t)b * 256 + rho) * 2048 + n0 + 4 * fq;
                u32x2 wc_, ws_; wc_.x = cvt_pk_bf16(aC[0], aC[1]); wc_.y = cvt_pk_bf16(aC[2], aC[3]); ws_.x = cvt_pk_bf16(aS[0], aS[1]); ws_.y = cvt_pk_bf16(aS[2], aS[3]);
                *(u32x2*)dst = wc_; *(u32x2*)(dst + 1024) = ws_; }
            if (n0 == 0) {
                const bf16_t* xh = PROJ + (tokb + 1024) * INW + C_XC + 64 * gi + 8 * fq;
                const bf16x8 H0 = *(const bf16x8*)xh, H1 = *(const bf16x8*)(xh + 32);
#pragma unroll
                for (int ct = 0; ct < 4; ++ct) { const int cc = 16 * ct + fr;
                    const bf16x8 Bc0 = *(const LAS bf16x8*)(Ct + cc * 72 + 8 * fq), Bc1 = *(const LAS bf16x8*)(Ct + cc * 72 + 32 + 8 * fq);
                    f32x4 aH = (f32x4){0.f, 0.f, 0.f, 0.f};
                    aH = __builtin_amdgcn_mfma_f32_16x16x32_bf16(H0, Bc0, aH, 0, 0, 0); aH = __builtin_amdgcn_mfma_f32_16x16x32_bf16(H1, Bc1, aH, 0, 0, 0);
                    if (fq == 0) AH[b * 256 + 128 * (cc >> 5) + 32 * gi + (cc & 31)] = aH[0]; }
            }
        }
    }
    __syncthreads();
}

#define XB_TMO      128
#define XB_XCNT(j)  (256  + 64 * (j))
#define XB_XSUB(j)  (1280 + 64 * (j))
#define XB_XGEN(j)  (2304 + 64 * (j))
#define XB_TOP      3328
#define XB_TOPGEN   3392
#define XCD_BAR_WORDS 3456
#define XB_SPIN_CAP (1u << 18)
__device__ __forceinline__ unsigned xb_ld(unsigned* p)              { return __hip_atomic_load(p, __ATOMIC_RELAXED, __HIP_MEMORY_SCOPE_AGENT); }
__device__ __forceinline__ unsigned xb_add(unsigned* p, unsigned v) { return __hip_atomic_fetch_add(p, v, __ATOMIC_RELAXED, __HIP_MEMORY_SCOPE_AGENT); }
__device__ __forceinline__ unsigned xb_xcc_id() { return (unsigned)__builtin_amdgcn_s_getreg((3 << 11) | 20) & 0xFu; }
#define XB_SPIN(cond, bar) do { unsigned _sp = 0; while (cond) { __builtin_amdgcn_s_sleep(1); \
    if ((++_sp & 255u) == 0u) { if (xb_ld(&(bar)[XB_TMO])) break; if (_sp > XB_SPIN_CAP) { atomicAdd(&(bar)[XB_TMO], 1u); break; } } } } while (0)
struct XcdBarrier { unsigned* bar; unsigned x; volatile LAS unsigned* st; };
__device__ __forceinline__ XcdBarrier xcd_barrier_post(unsigned* bar, volatile LAS unsigned* st) {
    XcdBarrier b; b.bar = bar; b.x = xb_xcc_id(); b.st = st;
    if (threadIdx.x == 0) (void)xb_add(&bar[XB_XCNT(b.x)], 1u);
    return b;
}
__device__ __forceinline__ void xcd_barrier_complete(unsigned* bar, unsigned x, unsigned& nloc, unsigned& nx) {
    const unsigned G = gridDim.x * gridDim.y * gridDim.z;
    unsigned sum, cnt, mine, sp = 0u;
    for (;;) {
        sum = 0u; cnt = 0u; mine = 0u;
#pragma unroll
        for (unsigned j = 0; j < 16; ++j) { const unsigned c = xb_ld(&bar[XB_XCNT(j)]); sum += c; cnt += (c > 0u) ? 1u : 0u; mine = (j == x) ? c : mine; }
        if (sum == G) break;
        __builtin_amdgcn_s_sleep(1);
        if ((++sp & 255u) == 0u) { if (xb_ld(&bar[XB_TMO])) break; if (sp > XB_SPIN_CAP) { atomicAdd(&bar[XB_TMO], 1u); break; } }
    }
    nloc = mine > 0u ? mine : 1u; nx = cnt > 0u ? cnt : 1u;
}
__device__ __forceinline__ void xcd_barrier(const XcdBarrier& b) {
    asm volatile("s_waitcnt vmcnt(0)" ::: "memory");
    __syncthreads();
    if (threadIdx.x == 0) {
        unsigned* bar = b.bar;
        __builtin_amdgcn_s_waitcnt(0);
        unsigned nloc = b.st[0], nx = b.st[1];
        if (nloc == 0u) { xcd_barrier_complete(bar, b.x, nloc, nx); b.st[0] = nloc; b.st[1] = nx; }
        const unsigned old = xb_add(&bar[XB_XSUB(b.x)], 1u);
        const unsigned gen = old / nloc;
        if (old + 1u == (gen + 1u) * nloc) {
            __builtin_amdgcn_fence(__ATOMIC_RELEASE, "agent");
            asm volatile("s_waitcnt vmcnt(0)" ::: "memory");
            const unsigned og = xb_add(&bar[XB_TOP], 1u);
            const unsigned tg = og / nx;
            if (og + 1u == (tg + 1u) * nx) xb_add(&bar[XB_TOPGEN], 1u);
            else XB_SPIN(xb_ld(&bar[XB_TOPGEN]) == tg, bar);
            __builtin_amdgcn_fence(__ATOMIC_ACQUIRE, "agent");
            xb_add(&bar[XB_XGEN(b.x)], 1u);
            asm volatile("s_waitcnt vmcnt(0)" ::: "memory");
        } else {
            XB_SPIN(xb_ld(&bar[XB_XGEN(b.x)]) == gen, bar);
            __builtin_amdgcn_fence(__ATOMIC_ACQUIRE, "agent");
            asm volatile("s_waitcnt vmcnt(0)" ::: "memory");
        }
    }
    __syncthreads();
}
#define GRID_SYNC() xcd_barrier(xbar)

template <int l>
__device__ __forceinline__ void layer_body(const Args& a, LAS unsigned char* lds, const XcdBarrier& xbar) {
    int t_ = threadIdx.x; asm volatile("" : "+v"(t_));
    const int tid = t_, lane = tid & 63, wid = __builtin_amdgcn_readfirstlane(tid >> 6);
    const int G = gridDim.x, bx = blockIdx.x;
    const int gw = bx * 8 + wid, ngw = G * 8;
    unsigned char* ws = a.ws;
    const float* x_in = a.in[0];
    float* out = a.out;
    bf16_t* WIN = (bf16_t*)(ws + WS_WIN); bf16_t* WOUT = (bf16_t*)(ws + WS_WOUT); bf16_t* WGU = (bf16_t*)(ws + WS_WGU); bf16_t* WDN = (bf16_t*)(ws + WS_WDN);
    bf16_t* WSP = (bf16_t*)(ws + WS_WSP); bf16_t* TT = (bf16_t*)(ws + WS_T); u64* RSB = (u64*)(ws + WS_SSQ); u64* RSA = RSB + MTOK; float* AHB = (float*)(ws + WS_SSQ + 2 * MiB);
    bf16_t* XB = (bf16_t*)(ws + WS_XB); bf16_t* ABT = (bf16_t*)(ws + WS_ABT); bf16_t* PROJ = (bf16_t*)(ws + WS_PROJ); bf16_t* MIX = (bf16_t*)(ws + WS_MIX); bf16_t* HID = (bf16_t*)(ws + WS_HID);
        { pg8::Gemm g{XB, WIN + (size_t)l * INW * DM, MTOK, INW, DM}; pg8::StaticOrder S; S.init(MTOK, INW, G, bx);
          pg8::EpiProj E{PROJ, INW, RSB};
          pg8::gemm_phase<pg8::EpiProj, pg8::StaticOrder, true, true>(lds, g, S, E); }
        GRID_SYNC();
        for (int i = bx * 512 + tid; i < 2 * MTOK; i += G * 512) RSB[i] = 0ull;
        for (int it = bx; it < NBATCH * 8; it += G) attn_item(lds, PROJ, MIX, a.in[3] + (size_t)l * 8 * 465, it, tid, wid, lane);
        for (int it = bx; it < NBATCH * 16; it += G) gate_item(lds, PROJ, MIX, a.in[4] + l * 256, a.in[5] + l * 256, WSP + (size_t)l * 4 * 128 * 128, a.in[7] + l * 512, it, wid, lane);
        chan_dft(lds, PROJ, ABT, AHB, tid, gw, ngw, lane);
        GRID_SYNC();
        { pg8::Gemm g{TT, ABT, 2048, 8192, 2048}; pg8::DftOrder S; S.init(G, bx);
          pg8::EpiDft E{MIX, AHB};
          pg8::gemm_phase<pg8::EpiDft, pg8::DftOrder, true, true>(lds, g, S, E); }
        GRID_SYNC();
        { pg8::Gemm g{MIX, WOUT + (size_t)l * DM * DM, MTOK, DM, DM}; pg8::StaticOrder S; S.init(MTOK, DM, G, bx);
          pg8::EpiRes E{XB, RSA};
          pg8::gemm_phase<pg8::EpiRes, pg8::StaticOrder, true, true>(lds, g, S, E); }
        GRID_SYNC();
        { pg8::Gemm g{XB, WGU + (size_t)l * NGU * DM, MTOK, NGU, DM}; pg8::StaticOrder S; S.init(MTOK, NGU, G, bx);
          pg8::EpiGU E{HID, RSA};
          pg8::gemm_phase<pg8::EpiGU, pg8::StaticOrder, true, true>(lds, g, S, E); }
        GRID_SYNC();
        { pg8::Gemm g{HID, WDN + (size_t)l * DM * DFF, MTOK, DM, DFF}; pg8::StaticOrder S; S.init(MTOK, DM, G, bx);
          pg8::EpiRes E{XB, RSB};
          pg8::gemm_phase<pg8::EpiRes, pg8::StaticOrder, true, true>(lds, g, S, E); }
        GRID_SYNC();
}

__global__ void __launch_bounds__(512, 2) fwd_megakernel(Args a) {
    extern __shared__ __attribute__((aligned(16))) unsigned char lds_raw[];
    LAS unsigned char* lds = (LAS unsigned char*)lds_raw;
    cg::grid_group grid = cg::this_grid();
    volatile LAS unsigned* bst = (volatile LAS unsigned*)(lds + LDS_BYTES - 16);
    if (threadIdx.x == 0) { bst[0] = 0u; bst[1] = 0u; }
    __syncthreads();
    const XcdBarrier xbar = xcd_barrier_post((unsigned*)(a.ws + WS_CTL), bst);
    const int tid = threadIdx.x, lane = tid & 63, wid = __builtin_amdgcn_readfirstlane(tid >> 6);
    const int G = gridDim.x, bx = blockIdx.x;
    const int gw = bx * 8 + wid, ngw = G * 8;
    unsigned char* ws = a.ws;
    const float* x_in = a.in[0];
    float* out = a.out;
    bf16_t* WIN = (bf16_t*)(ws + WS_WIN); bf16_t* WOUT = (bf16_t*)(ws + WS_WOUT); bf16_t* WGU = (bf16_t*)(ws + WS_WGU); bf16_t* WDN = (bf16_t*)(ws + WS_WDN);
    bf16_t* WSP = (bf16_t*)(ws + WS_WSP); bf16_t* TT = (bf16_t*)(ws + WS_T); u64* RSB = (u64*)(ws + WS_SSQ); u64* RSA = RSB + MTOK; float* AHB = (float*)(ws + WS_SSQ + 2 * MiB);
    bf16_t* XB = (bf16_t*)(ws + WS_XB); bf16_t* ABT = (bf16_t*)(ws + WS_ABT); bf16_t* PROJ = (bf16_t*)(ws + WS_PROJ); bf16_t* MIX = (bf16_t*)(ws + WS_MIX); bf16_t* HID = (bf16_t*)(ws + WS_HID);

    {
        LAS float* scr = (LAS float*)(lds + wid * 8448);
        constexpr int I_IN = 16 * 72, I_OUT = 16 * 32, I_G = 16 * 88, I_D = 44 * 32, I_L = I_IN + I_OUT + 2 * I_G + I_D;
#pragma unroll 1
        for (int it = gw; it < DEPTH * I_L; it += ngw) {
            const int l = it / I_L; int r = it % I_L;
            if (r < I_IN) { const int kb = r / 72, nb = r % 72; transpose_item(a.in[2] + (size_t)l * DM * INW, DM, INW, WIN + (size_t)l * INW * DM, 32 * nb, a.in[1] + l * DM, (32 * nb < 512) ? 0.125f * 1.44269504f : 1.0f, scr, kb, nb, lane); continue; }
            r -= I_IN;
            if (r < I_OUT) { const int kb = r / 32, nb = r % 32; transpose_item(a.in[9] + (size_t)l * DM * DM, DM, DM, WOUT + (size_t)l * DM * DM, 32 * nb, a.in[8] + l * DM, 1.0f, scr, kb, nb, lane); continue; }
            r -= I_OUT;
            if (r < I_G) { const int kb = r / 88, nb = r % 88, n0 = 32 * nb; transpose_item(a.in[11] + (size_t)l * DM * DFF, DM, DFF, WGU + (size_t)l * NGU * DM, (n0 >> 7) * 256 + (n0 & 127), a.in[10] + l * DM, 1.0f, scr, kb, nb, lane); continue; }
            r -= I_G;
            if (r < I_G) { const int kb = r / 88, nb = r % 88, n0 = 32 * nb; transpose_item(a.in[12] + (size_t)l * DM * DFF, DM, DFF, WGU + (size_t)l * NGU * DM, (n0 >> 7) * 256 + 128 + (n0 & 127), a.in[10] + l * DM, 1.0f, scr, kb, nb, lane); continue; }
            r -= I_G;
            { const int kb = r / 32, nb = r % 32; transpose_item(a.in[13] + (size_t)l * DFF * DM, DFF, DM, WDN + (size_t)l * DM * DFF, 32 * nb, nullptr, 1.0f, scr, kb, nb, lane); }
        }
        for (int i = bx * 512 + tid; i < DEPTH * 4 * 128 * 128 / 2; i += G * 512) { const float2 v = ((const float2*)a.in[6])[i]; ((unsigned*)WSP)[i] = cvt_pk_bf16(v.x, v.y); }
#pragma unroll 1
        for (int i = bx * 512 + tid; i < 2048 * 2048 / 8; i += G * 512) { const int k = i >> 8, n8 = (i & 255) * 8; const bool sn = n8 >= 1024; const int nb = n8 & 1023;
            float v[8];
#pragma unroll
            for (int e = 0; e < 8; ++e) { const float ph = (float)((k * (nb + e)) & 2047) * (1.0f / 1024.0f); v[e] = (sn ? -sinpif(ph) : cospif(ph)) * 0.022097086912f; }
            u32x4 w; w.x = cvt_pk_bf16(v[0], v[1]); w.y = cvt_pk_bf16(v[2], v[3]); w.z = cvt_pk_bf16(v[4], v[5]); w.w = cvt_pk_bf16(v[6], v[7]);
            *(u32x4*)(TT + (size_t)k * 2048 + n8) = w; }
#pragma unroll 1
        for (int m0 = gw; m0 < MTOK; m0 += 4 * ngw) { f32x4 v[4][4];
#pragma unroll
            for (int q = 0; q < 4; ++q) { const f32x4* xr = (const f32x4*)(x_in + (size_t)(m0 + q * ngw) * DM) + lane;
#pragma unroll
                for (int jj = 0; jj < 4; ++jj) v[q][jj] = xr[64 * jj]; }
#pragma unroll
            for (int q = 0; q < 4; ++q) { const int m = m0 + q * ngw; float s = 0.f; u32x2* o8 = (u32x2*)(XB + (size_t)m * DM) + lane;
#pragma unroll
                for (int jj = 0; jj < 4; ++jj) { const f32x4 t = v[q][jj]; s += (t[0] * t[0] + t[1] * t[1]) + (t[2] * t[2] + t[3] * t[3]); u32x2 w; w.x = cvt_pk_bf16(t[0], t[1]); w.y = cvt_pk_bf16(t[2], t[3]); o8[64 * jj] = w; }
                s = wave_sum(s);
                if (lane == 0) RSB[m] = (u64)(s * RSS_SCALE); } }
    }
    GRID_SYNC();

    layer_body<0>(a, lds, xbar);
    layer_body<1>(a, lds, xbar); layer_body<2>(a, lds, xbar); layer_body<3>(a, lds, xbar);
    {
        const float* fg = a.in[14];
        f32x4 gv[4];
#pragma unroll
        for (int jj = 0; jj < 4; ++jj) gv[jj] = ((const f32x4*)fg)[lane + 64 * jj];
#pragma unroll 1
        for (int m0 = gw; m0 < MTOK; m0 += 4 * ngw) { u32x2 v[4][4];
#pragma unroll
            for (int q = 0; q < 4; ++q) { const u32x2* xr = (const u32x2*)(XB + (size_t)(m0 + q * ngw) * DM) + lane;
#pragma unroll
                for (int jj = 0; jj < 4; ++jj) v[q][jj] = xr[64 * jj]; }
#pragma unroll
            for (int q = 0; q < 4; ++q) { f32x4* xr = (f32x4*)(out + (size_t)(m0 + q * ngw) * DM) + lane; float s = 0.f; f32x4 t[4];
#pragma unroll
                for (int jj = 0; jj < 4; ++jj) { t[jj] = (f32x4){bf2f(v[q][jj].x & 0xffffu), bf2f(v[q][jj].x >> 16), bf2f(v[q][jj].y & 0xffffu), bf2f(v[q][jj].y >> 16)}; s += (t[jj][0] * t[jj][0] + t[jj][1] * t[jj][1]) + (t[jj][2] * t[jj][2] + t[jj][3] * t[jj][3]); }
                const float rs = rsqrtf(wave_sum(s) * (1.0f / 1024.0f) + EPS);
#pragma unroll
                for (int jj = 0; jj < 4; ++jj) xr[64 * jj] = t[jj] * rs * gv[jj]; } }
    }
    grid.sync();
}

extern "C" void kernel_launch(void* const* d_in, const int* in_sizes, int n_in, void* d_out, int out_size, void* d_ws, size_t ws_size, hipStream_t stream) {
    static int grid = 0;
    if (grid == 0) {
        if (n_in != 15 || in_sizes[0] != MTOK * DM || out_size != MTOK * DM || ws_size < WS_END) { fprintf(stderr, "kernel_launch: unexpected shapes (n_in %d, in0 %d, out %d, ws %zu)\n", n_in, n_in > 0 ? in_sizes[0] : -1, out_size, ws_size); grid = -1; return; }
        int dev = 0, cus = 0, per_cu = 0;
        hipGetDevice(&dev);
        hipDeviceGetAttribute(&cus, hipDeviceAttributeMultiprocessorCount, dev);
        if (hipFuncSetAttribute((const void*)fwd_megakernel, hipFuncAttributeMaxDynamicSharedMemorySize, LDS_BYTES) != hipSuccess) { fprintf(stderr, "kernel_launch: hipFuncSetAttribute(%d B dynamic LDS) failed\n", LDS_BYTES); grid = -1; return; }
        if (hipOccupancyMaxActiveBlocksPerMultiprocessor(&per_cu, (const void*)fwd_megakernel, 512, LDS_BYTES) != hipSuccess || per_cu < 1) { fprintf(stderr, "kernel_launch: occupancy query says %d blocks per CU\n", per_cu); (void)hipGetLastError(); per_cu = 1; }
        grid = cus * per_cu;
        fprintf(stderr, "kernel_launch: grid %d (cus %d x %d)\n", grid, cus, per_cu);
    }
    if (grid < 0) return;
    if (hipMemsetAsync((char*)d_ws + WS_CTL, 0, 16384, stream) != hipSuccess) { fprintf(stderr, "kernel_launch: memset of the barrier word failed\n"); return; }
    Args a{};
    for (int i = 0; i < 15; ++i) a.in[i] = (const float*)d_in[i];
    a.out = (float*)d_out; a.ws = (unsigned char*)d_ws;
    void* args[] = {&a};
    hipError_t e = hipLaunchCooperativeKernel((const void*)fwd_megakernel, dim3(grid), dim3(512), args, LDS_BYTES, stream);
    if (e != hipSuccess) fprintf(stderr, "cooperative launch failed: %s (grid %d)\n", hipGetErrorString(e), grid);
}
```

```cpp
#include <hip/hip_runtime.h>
#include <hip/hip_cooperative_groups.h>
#include <cstdio>
#include <cstdint>
namespace cg = cooperative_groups;

#define LAS __attribute__((address_space(3)))
typedef unsigned short bf16_t;
typedef short bf16x8 __attribute__((ext_vector_type(8)));
typedef float f32x4 __attribute__((ext_vector_type(4)));
typedef unsigned u32x4 __attribute__((ext_vector_type(4)));
typedef unsigned u32x2 __attribute__((ext_vector_type(2)));

constexpr int DM = 1024, NBATCH = 32, SEQ = 2048, DEPTH = 4, MTOK = NBATCH * SEQ;
constexpr int INW = 2304, DFF = 2816, NGU = 2 * DFF;
constexpr int C_Q = 0, C_K = 512, C_V = 1024, C_U = 1536, C_VG = 1792, C_XC = 2048;
constexpr float EPS = 1e-6f;
constexpr int LDS_BYTES = 155648;

constexpr size_t MiB = 1u << 20;
constexpr size_t SZ_WIN = (size_t)INW * DM * 2, SZ_WOUT = (size_t)DM * DM * 2, SZ_WGU = (size_t)NGU * DM * 2, SZ_WDN = (size_t)DM * DFF * 2;
constexpr size_t WS_WIN = 0;
constexpr size_t WS_WOUT = 18 * MiB;
constexpr size_t WS_WGU = 26 * MiB;
constexpr size_t WS_WDN = 70 * MiB;
constexpr size_t WS_WSP = 92 * MiB;
constexpr size_t WS_T = 93 * MiB;
constexpr size_t WS_SSQ = 109 * MiB;
constexpr size_t WS_XB = 113 * MiB;
constexpr size_t WS_ABT = 241 * MiB;
constexpr size_t WS_PROJ = 305 * MiB;
constexpr size_t WS_MIX = 593 * MiB;
constexpr size_t WS_HID = WS_PROJ;
constexpr size_t WS_CTL = 721 * MiB;
constexpr size_t WS_END = 722 * MiB;
static_assert(4 * SZ_WIN <= 18 * MiB && 4 * SZ_WGU <= 44 * MiB && 4 * SZ_WDN <= 22 * MiB && (size_t)MTOK * DFF * 2 <= 416 * MiB, "ws map");

typedef __bf16 bf16v2 __attribute__((ext_vector_type(2)));
typedef float f32v2 __attribute__((ext_vector_type(2)));
__device__ __forceinline__ unsigned cvt_pk_bf16(float lo, float hi) { const f32v2 v = {lo, hi}; const bf16v2 b = __builtin_convertvector(v, bf16v2); return __builtin_bit_cast(unsigned, b); }
__device__ __forceinline__ float bf2f(unsigned h) { return __uint_as_float(h << 16); }
__device__ __forceinline__ float gelu_tanh(float x) { const float t = -2.3022082f * (x + 0.044715f * x * x * x); return x * __builtin_amdgcn_rcpf(1.0f + __builtin_amdgcn_exp2f(t)); }
__device__ __forceinline__ float silu_f(float x) { return x * __builtin_amdgcn_rcpf(1.0f + __builtin_amdgcn_exp2f(-1.44269504f * x)); }
__device__ __forceinline__ float wave_sum(float v) {
#pragma unroll
    for (int o = 1; o < 64; o <<= 1) v += __shfl_xor(v, o);
    return v;
}
typedef unsigned long long u64;
constexpr float RSS_SCALE = 16777216.0f;
__device__ __forceinline__ float row_rs(const u64* rss, int row) { return rsqrtf((float)rss[row] * (1.0f / (RSS_SCALE * 1024.0f)) + EPS); }
__device__ __forceinline__ void headnorm_store(f32x4 (&o)[4], bf16_t* dst) {
    float ss = 0.f;
#pragma unroll
    for (int dg = 0; dg < 4; ++dg) ss += (o[dg][0] * o[dg][0] + o[dg][1] * o[dg][1]) + (o[dg][2] * o[dg][2] + o[dg][3] * o[dg][3]);
    ss += __shfl_xor(ss, 16); ss += __shfl_xor(ss, 32);
    const float sc = rsqrtf(ss * (1.0f / 64.0f) + EPS);
#pragma unroll
    for (int dg = 0; dg < 4; ++dg) { u32x2 w; w.x = cvt_pk_bf16(o[dg][0] * sc, o[dg][1] * sc); w.y = cvt_pk_bf16(o[dg][2] * sc, o[dg][3] * sc); *(u32x2*)(dst + 16 * dg) = w; }
}

namespace pg8 {
constexpr int BM = 256, BK = 64, HALF = 128, HTB = HALF * BK * 2, STAGE_BYTES = 8 * HTB, NXCD = 8, WGM = 8;
__host__ __device__ __forceinline__ int lds_byte(int r, int c) { const int st = (r >> 4) * 2 + (c >> 5), rr = r & 15, cc = c & 31, ob = rr * 64 + cc * 2; return st * 1024 + (ob ^ (((ob >> 9) & 1) << 5)); }
__host__ __device__ __forceinline__ void stage_rc(int b, int& R, int& C) { const int st = b / 1024, sb = b % 1024, swz = sb ^ (((sb >> 9) & 1) << 5); R = (st >> 1) * 16 + swz / 64; C = (st & 1) * 32 + (swz % 64) / 2; }
__host__ __device__ __forceinline__ int perm32(int rho) { const int n = rho >> 4, i = rho & 15; return 8 * (i >> 2) + 4 * n + (i & 3); }

struct Unit { int pm, pn; };
struct Gemm { const bf16_t* A; const bf16_t* Bt; int M, N, K; };

struct StaticOrder {
    int nM, nN, nwg, G, c;
    __device__ void init(int M, int N, int G_, int c_) { nM = M / BM; nN = N / BM; nwg = nM * nN; G = G_; c = c_; }
    __device__ bool next(int i, Unit& u) const {
        const long L = (long)i * G + c; if (L >= nwg) return false;
        int wgid = (int)L; { const int q = nwg / NXCD, r = nwg % NXCD, xcd = wgid % NXCD, off = wgid / NXCD; wgid = (xcd < r ? xcd * (q + 1) : r * (q + 1) + (xcd - r) * q) + off; }
        const int nig = WGM * nN, gid = wgid / nig, fm = gid * WGM, gsz = (nM - fm) < WGM ? (nM - fm) : WGM;
        u.pm = fm + ((wgid % nig) % gsz); u.pn = (wgid % nig) / gsz; return true;
    }
    __device__ __forceinline__ void a_ready(const Unit&) const {}
    __device__ __forceinline__ void done(const Unit&) const {}
};
struct DftOrder {
    int G, c;
    __device__ void init(int G_, int c_) { G = G_; c = c_; }
    __device__ bool next(int i, Unit& u) const {
        const long L = (long)i * G + c; if (L >= 256) return false;
        const int x = (int)L & 7, j = (int)L >> 3; u.pm = j & 7; u.pn = x * 4 + (j >> 3); return true;
    }
    __device__ __forceinline__ void a_ready(const Unit&) const {}
    __device__ __forceinline__ void done(const Unit&) const {}
};

struct EpiProj {
    static constexpr bool PERM = true, AFTER_DRAIN = false;
    bf16_t* O; int ldc; const u64* ssq;
    __device__ __forceinline__ void operator()(const f32x4 (&acc)[2][2][4][2], const Unit& u, int wr, int wc, int fr, int fq) const {
        const int row0 = u.pm * BM + wr * 64 + fr, col0 = u.pn * BM + wc * 32 + 8 * fq;
        float rsv[2][4];
#pragma unroll
        for (int ai = 0; ai < 2; ++ai)
#pragma unroll
            for (int m = 0; m < 4; ++m) rsv[ai][m] = row_rs(ssq, row0 + ai * HALF + m * 16);
#pragma unroll
        for (int ai = 0; ai < 2; ++ai)
#pragma unroll
            for (int m = 0; m < 4; ++m) { const int row = row0 + ai * HALF + m * 16; const float rs = rsv[ai][m]; bf16_t* rowp = O + (size_t)row * ldc + col0;
#pragma unroll
                for (int bj = 0; bj < 2; ++bj) { const f32x4 v0 = acc[ai][bj][m][0] * rs, v1 = acc[ai][bj][m][1] * rs;
                    u32x4 w; w.x = cvt_pk_bf16(v0[0], v0[1]); w.y = cvt_pk_bf16(v0[2], v0[3]); w.z = cvt_pk_bf16(v1[0], v1[1]); w.w = cvt_pk_bf16(v1[2], v1[3]);
                    *(u32x4*)(rowp + bj * HALF) = w; } }
    }
};
struct EpiGU {
    static constexpr bool PERM = true, AFTER_DRAIN = false;
    bf16_t* O; const u64* ssq;
    __device__ __forceinline__ void operator()(const f32x4 (&acc)[2][2][4][2], const Unit& u, int wr, int wc, int fr, int fq) const {
        const int row0 = u.pm * BM + wr * 64 + fr, col0 = u.pn * HALF + wc * 32 + 8 * fq;
        float rsv[2][4];
#pragma unroll
        for (int ai = 0; ai < 2; ++ai)
#pragma unroll
            for (int m = 0; m < 4; ++m) rsv[ai][m] = row_rs(ssq, row0 + ai * HALF + m * 16);
#pragma unroll
        for (int ai = 0; ai < 2; ++ai)
#pragma unroll
            for (int m = 0; m < 4; ++m) { const int row = row0 + ai * HALF + m * 16; const float rs = rsv[ai][m];
                f32x4 h[2];
#pragma unroll
                for (int n = 0; n < 2; ++n) { const f32x4 g = acc[ai][0][m][n] * rs, up = acc[ai][1][m][n] * rs;
#pragma unroll
                    for (int e = 0; e < 4; ++e) h[n][e] = silu_f(g[e]) * up[e]; }
                u32x4 w; w.x = cvt_pk_bf16(h[0][0], h[0][1]); w.y = cvt_pk_bf16(h[0][2], h[0][3]); w.z = cvt_pk_bf16(h[1][0], h[1][1]); w.w = cvt_pk_bf16(h[1][2], h[1][3]);
                *(u32x4*)(O + (size_t)row * DFF + col0) = w; }
    }
};
struct EpiRes {
    static constexpr bool PERM = true, AFTER_DRAIN = false;
    bf16_t* xb; u64* ssq;
    __device__ __forceinline__ void operator()(const f32x4 (&acc)[2][2][4][2], const Unit& u, int wr, int wc, int fr, int fq) const {
        const int row0 = u.pm * BM + wr * 64 + fr, col0 = u.pn * BM + wc * 32 + 8 * fq;
        u32x4 bb[2][2];
#define RES_LOAD(idx) do { const size_t off_ = (size_t)(row0 + ((idx) >> 2) * HALF + ((idx) & 3) * 16) * DM + col0; \
            bb[(idx) & 1][0] = *(const u32x4*)(xb + off_); bb[(idx) & 1][1] = *(const u32x4*)(xb + off_ + HALF); } while (0)
        RES_LOAD(0);
        asm volatile("" ::: "memory");
#pragma unroll
        for (int idx = 0; idx < 8; ++idx) { const int ai = idx >> 2, m = idx & 3; const int row = row0 + ai * HALF + m * 16; const size_t off = (size_t)row * DM + col0; float ss = 0.f;
            if (idx < 7) RES_LOAD(idx + 1);
#pragma unroll
            for (int bj = 0; bj < 2; ++bj) { const u32x4 b = bb[idx & 1][bj];
                const f32x4 r0 = (f32x4){bf2f(b.x & 0xffffu), bf2f(b.x >> 16), bf2f(b.y & 0xffffu), bf2f(b.y >> 16)}, r1 = (f32x4){bf2f(b.z & 0xffffu), bf2f(b.z >> 16), bf2f(b.w & 0xffffu), bf2f(b.w >> 16)};
                const f32x4 v0 = r0 + acc[ai][bj][m][0], v1 = r1 + acc[ai][bj][m][1];
                u32x4 w; w.x = cvt_pk_bf16(v0[0], v0[1]); w.y = cvt_pk_bf16(v0[2], v0[3]); w.z = cvt_pk_bf16(v1[0], v1[1]); w.w = cvt_pk_bf16(v1[2], v1[3]);
                *(u32x4*)(xb + off + bj * HALF) = w;
                ss += (v0[0] * v0[0] + v0[1] * v0[1]) + (v0[2] * v0[2] + v0[3] * v0[3]) + (v1[0] * v1[0] + v1[1] * v1[1]) + (v1[2] * v1[2] + v1[3] * v1[3]); }
            ss += __shfl_xor(ss, 16); ss += __shfl_xor(ss, 32);
            if (fq == 0) (void)__hip_atomic_fetch_add(ssq + row, (u64)(ss * RSS_SCALE), __ATOMIC_RELAXED, __HIP_MEMORY_SCOPE_AGENT);
            asm volatile("" ::: "memory"); }
#undef RES_LOAD
    }
};
struct EpiDft {
    static constexpr bool PERM = true, AFTER_DRAIN = false;
    bf16_t* mix; const float* ah;
    __device__ __forceinline__ void operator()(const f32x4 (&acc)[2][2][4][2], const Unit& u, int wr, int wc, int fr, int fq) const {
        const int row0 = u.pn * SEQ + u.pm * BM + wr * 64 + fr;
        const float sg = (fr & 1) ? -0.022097086912f : 0.022097086912f;
        f32x4 hv[2][2];
#pragma unroll
        for (int bj = 0; bj < 2; ++bj)
#pragma unroll
            for (int n = 0; n < 2; ++n) hv[bj][n] = *(const f32x4*)(ah + u.pn * 256 + 128 * bj + 32 * wc + 8 * fq + 4 * n) * sg;
#pragma unroll
        for (int ai = 0; ai < 2; ++ai)
#pragma unroll
            for (int m = 0; m < 4; ++m) { const int row = row0 + ai * HALF + m * 16; float ss = 0.f; f32x4 v[2][2];
#pragma unroll
                for (int bj = 0; bj < 2; ++bj)
#pragma unroll
                    for (int n = 0; n < 2; ++n) { v[bj][n] = acc[ai][bj][m][n] + hv[bj][n]; ss += (v[bj][n][0] * v[bj][n][0] + v[bj][n][1] * v[bj][n][1]) + (v[bj][n][2] * v[bj][n][2] + v[bj][n][3] * v[bj][n][3]); }
                ss += __shfl_xor(ss, 16); ss += __shfl_xor(ss, 32);
                const float sc = rsqrtf(ss * (1.0f / 64.0f) + EPS);
                bf16_t* rowp = mix + (size_t)row * DM + 768 + 64 * wc + 8 * fq;
#pragma unroll
                for (int bj = 0; bj < 2; ++bj) { const f32x4 v0 = v[bj][0] * sc, v1 = v[bj][1] * sc;
                    u32x4 w; w.x = cvt_pk_bf16(v0[0], v0[1]); w.y = cvt_pk_bf16(v0[2], v0[3]); w.z = cvt_pk_bf16(v1[0], v1[1]); w.w = cvt_pk_bf16(v1[2], v1[3]);
                    *(u32x4*)(rowp + 32 * bj) = w; }
                asm volatile("" ::: "memory"); }
    }
};

template <class Epi, class Sched, bool ALIGN_EPI = false, bool SP2 = false>
__device__ __forceinline__ void gemm_phase(LAS unsigned char* lds, const Gemm g, const Sched& S, const Epi& E) {
    int tid_ = threadIdx.x; asm volatile("" : "+v"(tid_));
    const int tid = tid_, wid = __builtin_amdgcn_readfirstlane(tid >> 6), lane = tid & 63, wr = wid >> 2, wc = wid & 3, fr = lane & 15, fq = lane >> 4;
    const int K = g.K, nt = K / BK;
    unsigned voffA[2], voffB[2];
#pragma unroll
    for (int i = 0; i < 2; ++i) { int R, C; stage_rc(tid * 16 + i * 8192, R, C); const int Rb = Epi::PERM ? ((R & ~31) + perm32(R & 31)) : R;
        voffA[i] = (unsigned)(R * K + C) * 2u; voffB[i] = (unsigned)(Rb * K + C) * 2u; }
    const size_t kstep = (size_t)(BK * 2);
    const size_t hstep = (size_t)HALF * K * 2;
    const size_t tstep = 2 * hstep;
    const unsigned ldsw = (unsigned)wid * 1024u;
    const int aoff = lds_byte(wr * 64 + fr, fq * 8), boff = lds_byte(wc * 32 + fr, fq * 8);
#define PG8_SA(b, h) (((b) * 2 + (h)) * HTB)
#define PG8_SB(b, h) ((4 + (b) * 2 + (h)) * HTB)
#define PG8_STAGE(bufoff, gbase, voff) do { _Pragma("unroll") for (int _i = 0; _i < 2; ++_i) \
        __builtin_amdgcn_global_load_lds((const unsigned*)((const char*)(gbase) + (voff)[_i]), (LAS unsigned*)(lds + (bufoff) + ldsw + _i * 8192), 16, 0, 0); } while (0)
#define PG8_LDA(dst, b, h) do { _Pragma("unroll") for (int m = 0; m < 4; ++m) _Pragma("unroll") for (int k = 0; k < 2; ++k) dst[m][k] = *(const LAS bf16x8*)(lds + PG8_SA(b, h) + aoff + m * 2048 + k * 1024); } while (0)
#define PG8_LDB(dst, b, h) do { _Pragma("unroll") for (int n = 0; n < 2; ++n) _Pragma("unroll") for (int k = 0; k < 2; ++k) dst[n][k] = *(const LAS bf16x8*)(lds + PG8_SB(b, h) + boff + n * 2048 + k * 1024); } while (0)
#define PG8_MMA(ai, bj, At, Bt) do { __builtin_amdgcn_s_setprio(1); _Pragma("unroll") for (int m = 0; m < 4; ++m) _Pragma("unroll") for (int n = 0; n < 2; ++n) _Pragma("unroll") for (int k = 0; k < 2; ++k) \
        acc[ai][bj][m][n] = __builtin_amdgcn_mfma_f32_16x16x32_bf16(Bt[n][k], At[m][k], acc[ai][bj][m][n], 0, 0, 0); __builtin_amdgcn_s_setprio(0); } while (0)
#define PG8_WAIT_V(n) asm volatile("s_waitcnt vmcnt(" #n ")" ::: "memory")
#define PG8_WAIT_L(n) asm volatile("s_waitcnt lgkmcnt(" #n ")" ::: "memory")
#define PG8_BAR __builtin_amdgcn_s_barrier()
#define PG8_SCHED __builtin_amdgcn_sched_barrier(0)
    Unit cur, nxt; int ui = 0;
    if (!S.next(0, cur)) return;
    f32x4 acc[2][2][4][2];
#pragma unroll
    for (int a = 0; a < 2; ++a)
#pragma unroll
        for (int b = 0; b < 2; ++b)
#pragma unroll
            for (int m = 0; m < 4; ++m)
#pragma unroll
                for (int n = 0; n < 2; ++n) acc[a][b][m][n] = (f32x4){0.f, 0.f, 0.f, 0.f};
    bf16x8 At[4][2], B0[2][2], B1[2][2];
    const char* cA = (const char*)g.A + (size_t)cur.pm * tstep; const char* cB = (const char*)g.Bt + (size_t)cur.pn * tstep;
    S.a_ready(cur);
    if constexpr (SP2) {
        PG8_STAGE(PG8_SB(0, 0), cB, voffB); PG8_STAGE(PG8_SB(0, 1), cB + hstep, voffB); PG8_STAGE(PG8_SA(0, 0), cA, voffA); PG8_STAGE(PG8_SA(0, 1), cA + hstep, voffA);
        if (wr == 1) PG8_BAR;
        PG8_WAIT_V(2); PG8_BAR;
        PG8_STAGE(PG8_SB(1, 0), cB + kstep, voffB); PG8_STAGE(PG8_SA(1, 0), cA + kstep, voffA); PG8_STAGE(PG8_SB(1, 1), cB + hstep + kstep, voffB);
        PG8_WAIT_V(6); PG8_BAR;
    } else {
        PG8_STAGE(PG8_SB(0, 0), cB, voffB); PG8_STAGE(PG8_SA(0, 0), cA, voffA); PG8_STAGE(PG8_SB(0, 1), cB + hstep, voffB); PG8_STAGE(PG8_SA(0, 1), cA + hstep, voffA);
        if (wr == 1) PG8_BAR;
        PG8_WAIT_V(4); PG8_BAR;
        PG8_STAGE(PG8_SB(1, 0), cB + kstep, voffB); PG8_STAGE(PG8_SA(1, 0), cA + kstep, voffA); PG8_STAGE(PG8_SB(1, 1), cB + hstep + kstep, voffB);
        PG8_WAIT_V(6); PG8_BAR;
    }
    for (;;) {
        const bool has_next = S.next(ui + 1, nxt);
        const char* nA = has_next ? (const char*)g.A + (size_t)nxt.pm * tstep : cA; const char* nB = has_next ? (const char*)g.Bt + (size_t)nxt.pn * tstep : cB;
        for (int t = 0; t < nt; t += 2) {
            const bool last = (t == nt - 2);
            const char* a1 = cA + (size_t)(t + 1) * kstep;
            const char* a2 = last ? nA : cA + (size_t)(t + 2) * kstep; const char* b2 = last ? nB : cB + (size_t)(t + 2) * kstep;
            const char* a3 = a2 + kstep; const char* b3 = b2 + kstep;
            if (last && has_next) S.a_ready(nxt);
            if constexpr (SP2) {
            PG8_LDB(B0, 0, 0); PG8_LDB(B1, 0, 1); PG8_SCHED; PG8_LDA(At, 0, 0); PG8_STAGE(PG8_SA(1, 1), a1 + hstep, voffA);
            PG8_WAIT_V(8); PG8_WAIT_L(0); PG8_BAR; PG8_MMA(0, 0, At, B0); PG8_MMA(0, 1, At, B1); PG8_BAR; PG8_SCHED;
            PG8_LDA(At, 0, 1); PG8_STAGE(PG8_SB(0, 0), b2, voffB); PG8_STAGE(PG8_SB(0, 1), b2 + hstep, voffB); PG8_STAGE(PG8_SA(0, 0), a2, voffA);
            PG8_WAIT_V(8); PG8_WAIT_L(0); PG8_BAR; PG8_MMA(1, 0, At, B0); PG8_MMA(1, 1, At, B1); PG8_BAR; PG8_SCHED;
            PG8_LDB(B0, 1, 0); PG8_LDB(B1, 1, 1); PG8_SCHED; PG8_LDA(At, 1, 0); PG8_STAGE(PG8_SA(0, 1), a2 + hstep, voffA);
            PG8_WAIT_V(8); PG8_WAIT_L(0); PG8_BAR; PG8_MMA(0, 0, At, B0); PG8_MMA(0, 1, At, B1); PG8_BAR; PG8_SCHED;
            PG8_LDA(At, 1, 1); PG8_STAGE(PG8_SB(1, 0), b3, voffB); PG8_STAGE(PG8_SB(1, 1), b3 + hstep, voffB); PG8_STAGE(PG8_SA(1, 0), a3, voffA);
            PG8_WAIT_V(8); PG8_WAIT_L(0); PG8_BAR; PG8_MMA(1, 0, At, B0); PG8_MMA(1, 1, At, B1); PG8_BAR; PG8_SCHED;
            } else {
            PG8_LDB(B0, 0, 0); PG8_SCHED; PG8_LDA(At, 0, 0); PG8_STAGE(PG8_SA(1, 1), a1 + hstep, voffA);
            PG8_WAIT_L(8); PG8_BAR; PG8_WAIT_L(0); PG8_MMA(0, 0, At, B0); PG8_BAR; PG8_SCHED;
            PG8_LDB(B1, 0, 1); PG8_STAGE(PG8_SB(0, 0), b2, voffB);
            PG8_BAR; PG8_WAIT_L(0); PG8_MMA(0, 1, At, B1); PG8_BAR;
            PG8_LDA(At, 0, 1); PG8_STAGE(PG8_SA(0, 0), a2, voffA);
            PG8_BAR; PG8_WAIT_L(0); PG8_MMA(1, 0, At, B0); PG8_BAR; PG8_SCHED;
            PG8_STAGE(PG8_SB(0, 1), b2 + hstep, voffB);
            PG8_WAIT_V(6); PG8_BAR; PG8_MMA(1, 1, At, B1); PG8_BAR;
            PG8_LDB(B0, 1, 0); PG8_SCHED; PG8_LDA(At, 1, 0); PG8_STAGE(PG8_SA(0, 1), a2 + hstep, voffA);
            PG8_WAIT_L(8); PG8_BAR; PG8_WAIT_L(0); PG8_MMA(0, 0, At, B0); PG8_BAR; PG8_SCHED;
            PG8_LDB(B1, 1, 1); PG8_STAGE(PG8_SB(1, 0), b3, voffB);
            PG8_BAR; PG8_WAIT_L(0); PG8_MMA(0, 1, At, B1); PG8_BAR;
            PG8_LDA(At, 1, 1); PG8_STAGE(PG8_SA(1, 0), a3, voffA);
            PG8_BAR; PG8_WAIT_L(0); PG8_MMA(1, 0, At, B0); PG8_BAR; PG8_SCHED;
            PG8_STAGE(PG8_SB(1, 1), b3 + hstep, voffB);
            PG8_WAIT_V(6); PG8_BAR; PG8_MMA(1, 1, At, B1); PG8_BAR;
            }
        }
        if constexpr (ALIGN_EPI) { if (wr == 0) PG8_BAR; }
        if constexpr (!Epi::AFTER_DRAIN) { E(acc, cur, wr, wc, fr, fq); S.done(cur); }
        if (!has_next) break;
#pragma unroll
        for (int a = 0; a < 2; ++a)
#pragma unroll
            for (int b = 0; b < 2; ++b)
#pragma unroll
                for (int m = 0; m < 4; ++m)
#pragma unroll
                    for (int n = 0; n < 2; ++n) acc[a][b][m][n] = (f32x4){0.f, 0.f, 0.f, 0.f};
        cur = nxt; cA = nA; cB = nB; ++ui;
        if constexpr (ALIGN_EPI) { if (wr == 1) PG8_BAR; }
    }
    PG8_WAIT_V(0);
    if constexpr (!ALIGN_EPI) { if (wr == 0) PG8_BAR; }
    PG8_BAR;
#undef PG8_SA
#undef PG8_SB
#undef PG8_STAGE
#undef PG8_LDA
#undef PG8_LDB
#undef PG8_MMA
#undef PG8_WAIT_V
#undef PG8_WAIT_L
#undef PG8_BAR
#undef PG8_SCHED
}
}

__device__ __forceinline__ void transpose_item(const float* W, int K, int N, bf16_t* WT, int drow0, const float* gk, float cs, int kb, int nb, int lane) {
    const int k0 = 64 * kb, n0 = 64 * nb;
    const float* wp = W + (size_t)k0 * N + n0 + lane;
    float v[64];
#pragma unroll
    for (int j = 0; j < 64; ++j) v[j] = wp[(size_t)j * N];
    bf16_t* op = WT + (size_t)(drow0 + lane) * K + k0;
#pragma unroll
    for (int c = 0; c < 8; ++c) { float t[8];
#pragma unroll
        for (int e = 0; e < 8; ++e) t[e] = v[8 * c + e] * (gk ? gk[k0 + 8 * c + e] * cs : cs);
        u32x4 o; o.x = cvt_pk_bf16(t[0], t[1]); o.y = cvt_pk_bf16(t[2], t[3]); o.z = cvt_pk_bf16(t[4], t[5]); o.w = cvt_pk_bf16(t[6], t[7]);
        *(u32x4*)(op + 8 * c) = o; }
}

struct Args { const float* in[15]; float* out; unsigned char* ws; };

__device__ __forceinline__ void attn_item(LAS unsigned char* lds, const bf16_t* PROJ, bf16_t* MIX, const float* rpb_l, int item, int tid, int wid, int lane) {
    const int b = item >> 3, h = item & 7, fr = lane & 15, fq = lane >> 4;
    LAS unsigned char* Kl = lds; LAS unsigned char* Vl = lds + 73728; LAS float* bias = (LAS float*)(lds + 147456);
    for (int i = tid; i < 480; i += 512) { const int dr_ = i >> 5, dc_ = i & 31; bias[i] = dc_ < 31 ? rpb_l[h * 465 + dr_ * 31 + dc_] * 1.44269504f : -INFINITY; }
    const bf16_t* base = PROJ + (size_t)b * SEQ * INW + h * 64;
    const int lkey = tid >> 2, lcp = tid & 3, lrow = lkey >> 6, lkc = lkey & 63;
    u32x4 kreg0, kreg1, vreg0, vreg1;
    kreg0 = kreg1 = vreg0 = vreg1 = (u32x4){0u, 0u, 0u, 0u};
#define ATT_LOAD(row_lo, cnt) do { if (lrow < (cnt)) { const bf16_t* p_ = base + (size_t)(((row_lo) + lrow) * 64 + lkc) * INW + C_K + lcp * 16; \
        kreg0 = *(const u32x4*)p_; kreg1 = *(const u32x4*)(p_ + 8); vreg0 = *(const u32x4*)(p_ + 512); vreg1 = *(const u32x4*)(p_ + 520); } } while (0)
#define ATT_STORE(row_lo, cnt) do { if (lrow < (cnt)) { const int slot_ = ((row_lo) + lrow) % 9; const int sw_ = (lkc >> 1) & 7; \
        LAS unsigned char* kp_ = Kl + slot_ * 8192 + lkc * 128; \
        *(LAS u32x4*)(kp_ + (((2 * lcp) ^ sw_) << 4)) = kreg0; *(LAS u32x4*)(kp_ + (((2 * lcp + 1) ^ sw_) << 4)) = kreg1; \
        LAS unsigned char* vp_ = Vl + slot_ * 8192 + (lkc & 3) * 2; const int c8_ = lkc >> 2; \
        _Pragma("unroll") for (int e_ = 0; e_ < 8; ++e_) { const int d0_ = lcp * 16 + e_, d1_ = d0_ + 8; \
            const unsigned x0_ = (vreg0[e_ >> 1] >> (16 * (e_ & 1))) & 0xffffu, x1_ = (vreg1[e_ >> 1] >> (16 * (e_ & 1))) & 0xffffu; \
            *(LAS unsigned short*)(vp_ + d0_ * 128 + ((c8_ ^ (((d0_ >> 1) & 7) << 1)) << 3)) = (unsigned short)x0_; \
            *(LAS unsigned short*)(vp_ + d1_ * 128 + ((c8_ ^ (((d1_ >> 1) & 7) << 1)) << 3)) = (unsigned short)x1_; } } } while (0)
    for (int q = 0; q < 4; ++q) { ATT_LOAD(2 * q, 2); ATT_STORE(2 * q, 2); }
    int loaded = 8;
    __syncthreads();
    const int j = wid & 3, bs = min(max(16 * j - 8, 0), 32), qc = 16 * j + fr, wsq = min(max(qc - 8, 0), 48);
    const bf16_t* qbase = PROJ + ((size_t)b * SEQ + (wid >> 2) * 64 + qc) * INW + C_Q + h * 64 + fq * 8;
    bf16x8 bq0 = *(const bf16x8*)qbase, bq1 = *(const bf16x8*)(qbase + 32);
    int boff[8];
#pragma unroll
    for (int k = 0; k < 8; ++k) { const int kc = bs + 16 * (k >> 2) + 4 * fq + (k & 3); const bool inw = (kc >= wsq) && (kc < wsq + 16); boff[k] = (inw ? (kc - qc + 15) : 31) * 4; }
#pragma unroll 1
    for (int s = 0; s < 16; ++s) {
        const int need_next = (s < 15) ? (min(max(2 * (s + 1) - 3, 0), 24) + 8) : loaded;
        const int cnt = need_next - loaded;
        ATT_LOAD(loaded, cnt);
        {
            const int r = 2 * s + (wid >> 2), rs = min(max(r - 4, 0), 24);
            const size_t qtok = (size_t)b * SEQ + r * 64 + qc;
            const bf16_t* qn = qbase + (size_t)(s < 15 ? s + 1 : s) * 128 * INW;
            const bf16x8 bqn0 = *(const bf16x8*)qn, bqn1 = *(const bf16x8*)(qn + 32);
            f32x4 S[16];
            int slot = rs % 9;
            const int slot0 = slot;
#pragma unroll
            for (int i = 0; i < 8; ++i) {
#pragma unroll
                for (int hf = 0; hf < 2; ++hf) {
                    const int kc = bs + 16 * hf + fr, sw = (kc >> 1) & 7;
                    const LAS unsigned char* kp = Kl + slot * 8192 + kc * 128;
                    const bf16x8 a0 = *(const LAS bf16x8*)(kp + ((fq ^ sw) << 4)), a1 = *(const LAS bf16x8*)(kp + (((fq + 4) ^ sw) << 4));
                    f32x4 acc = (f32x4){0.f, 0.f, 0.f, 0.f};
                    acc = __builtin_amdgcn_mfma_f32_16x16x32_bf16(a0, bq0, acc, 0, 0, 0);
                    acc = __builtin_amdgcn_mfma_f32_16x16x32_bf16(a1, bq1, acc, 0, 0, 0);
                    S[2 * i + hf] = acc;
                }
                slot = (slot == 8) ? 0 : slot + 1;
            }
            float mx = -INFINITY;
            const LAS unsigned char* brow = (const LAS unsigned char*)bias + (rs - r + 7) * 128;
#pragma unroll
            for (int i = 0; i < 8; ++i)
#pragma unroll
                for (int k = 0; k < 8; ++k) { const float v = S[2 * i + (k >> 2)][k & 3] + *(const LAS float*)(brow + i * 128 + boff[k]); S[2 * i + (k >> 2)][k & 3] = v; mx = fmaxf(mx, v); }
            mx = fmaxf(mx, __shfl_xor(mx, 16)); mx = fmaxf(mx, __shfl_xor(mx, 32));
            float l = 0.f;
#pragma unroll
            for (int g = 0; g < 16; ++g)
#pragma unroll
                for (int e = 0; e < 4; ++e) { const float p = __builtin_amdgcn_exp2f(S[g][e] - mx); S[g][e] = p; l += p; }
            l += __shfl_xor(l, 16); l += __shfl_xor(l, 32);
            f32x4 o[4];
#pragma unroll
            for (int dg = 0; dg < 4; ++dg) o[dg] = (f32x4){0.f, 0.f, 0.f, 0.f};
            slot = slot0;
#pragma unroll
            for (int i = 0; i < 8; ++i) {
                u32x4 pw; pw.x = cvt_pk_bf16(S[2 * i][0], S[2 * i][1]); pw.y = cvt_pk_bf16(S[2 * i][2], S[2 * i][3]); pw.z = cvt_pk_bf16(S[2 * i + 1][0], S[2 * i + 1][1]); pw.w = cvt_pk_bf16(S[2 * i + 1][2], S[2 * i + 1][3]);
                const bf16x8 pb = __builtin_bit_cast(bf16x8, pw);
#pragma unroll
                for (int dg = 0; dg < 4; ++dg) { const int d = 16 * dg + fr, swv = ((d >> 1) & 7) << 1, cA = (bs >> 2) + fq, cB = cA + 4;
                    const LAS unsigned char* vp = Vl + slot * 8192 + d * 128;
                    const u32x2 lo = *(const LAS u32x2*)(vp + ((cA ^ swv) << 3)), hi = *(const LAS u32x2*)(vp + ((cB ^ swv) << 3));
                    const u32x4 aw = (u32x4){lo.x, lo.y, hi.x, hi.y};
                    o[dg] = __builtin_amdgcn_mfma_f32_16x16x32_bf16(__builtin_bit_cast(bf16x8, aw), pb, o[dg], 0, 0, 0); }
                slot = (slot == 8) ? 0 : slot + 1;
            }
            const float inv = __builtin_amdgcn_rcpf(l);
#pragma unroll
            for (int dg = 0; dg < 4; ++dg) o[dg] = o[dg] * inv;
            headnorm_store(o, MIX + qtok * DM + h * 64 + 4 * fq);
            bq0 = bqn0; bq1 = bqn1;
        }
        __syncthreads();
        ATT_STORE(loaded, cnt); loaded += cnt;
        __syncthreads();
    }
#undef ATT_LOAD
#undef ATT_STORE
}

__device__ __forceinline__ void gate_item(LAS unsigned char* lds, const bf16_t* PROJ, bf16_t* MIX, const float* lng, const float* lnb, const bf16_t* wsb, const float* bsp, int item, int wid, int lane) {
    const int fr = lane & 15, fq = lane >> 4;
    const size_t tok0 = (size_t)item * 128;
    constexpr int PITCH = 272;
    float g4[4], b4[4];
#pragma unroll
    for (int i = 0; i < 4; ++i) { g4[i] = lng[lane + 64 * i]; b4[i] = lnb[lane + 64 * i]; }
#pragma unroll 1
    for (int t0 = 0; t0 < 16; t0 += 4) {
        float v[4][4], s[4], s2[4];
#pragma unroll
        for (int uu = 0; uu < 4; ++uu) { const bf16_t* zp = PROJ + (tok0 + 16 * wid + t0 + uu) * INW + C_VG;
#pragma unroll
            for (int i = 0; i < 4; ++i) v[uu][i] = bf2f(zp[lane + 64 * i]); }
#pragma unroll
        for (int uu = 0; uu < 4; ++uu) { s[uu] = 0.f;
#pragma unroll
            for (int i = 0; i < 4; ++i) { v[uu][i] = gelu_tanh(v[uu][i]); s[uu] += v[uu][i]; } }
#pragma unroll
        for (int o = 1; o < 64; o <<= 1)
#pragma unroll
            for (int uu = 0; uu < 4; ++uu) s[uu] += __shfl_xor(s[uu], o);
#pragma unroll
        for (int uu = 0; uu < 4; ++uu) { const float mean = s[uu] * (1.0f / 256.0f); s2[uu] = 0.f;
#pragma unroll
            for (int i = 0; i < 4; ++i) { v[uu][i] -= mean; s2[uu] += v[uu][i] * v[uu][i]; } }
#pragma unroll
        for (int o = 1; o < 64; o <<= 1)
#pragma unroll
            for (int uu = 0; uu < 4; ++uu) s2[uu] += __shfl_xor(s2[uu], o);
#pragma unroll
        for (int uu = 0; uu < 4; ++uu) { const float rstd = rsqrtf(s2[uu] * (1.0f / 256.0f) + EPS); const int q = 16 * wid + t0 + uu;
#pragma unroll
            for (int i = 0; i < 4; ++i) { const float y = v[uu][i] * rstd * g4[i] + b4[i]; *(LAS unsigned short*)(lds + (lane + 64 * i) * PITCH + q * 2) = (unsigned short)(cvt_pk_bf16(y, 0.f) & 0xffffu); } }
    }
    __syncthreads();
    const int hh = wid >> 1, ph = wid & 1;
#pragma unroll 2
    for (int pt4 = 0; pt4 < 4; ++pt4) { const int p = 16 * (4 * ph + pt4) + fr;
        bf16x8 B[4];
#pragma unroll
        for (int ks = 0; ks < 4; ++ks) B[ks] = *(const bf16x8*)(wsb + (size_t)(hh * 128 + p) * 128 + 32 * ks + 8 * fq);
        f32x4 o[4];
#pragma unroll
        for (int dg = 0; dg < 4; ++dg) { f32x4 acc = (f32x4){0.f, 0.f, 0.f, 0.f};
#pragma unroll
            for (int ks = 0; ks < 4; ++ks) { const bf16x8 A = *(const LAS bf16x8*)(lds + (64 * hh + 16 * dg + fr) * PITCH + (32 * ks + 8 * fq) * 2); acc = __builtin_amdgcn_mfma_f32_16x16x32_bf16(A, B[ks], acc, 0, 0, 0); }
            o[dg] = acc; }
        const size_t tok = tok0 + (16 * (4 * ph + pt4)) + (lane >> 4) * 0 + 0;
        const size_t mytok = tok + fr;
        const float bsv = bsp[hh * 128 + p];
        const bf16_t* up = PROJ + mytok * INW + C_U + 64 * hh + 4 * fq;
#pragma unroll
        for (int dg = 0; dg < 4; ++dg) { const u32x2 uw = *(const u32x2*)(up + 16 * dg);
            const float u0 = gelu_tanh(bf2f(uw.x & 0xffffu)), u1 = gelu_tanh(bf2f(uw.x >> 16)), u2 = gelu_tanh(bf2f(uw.y & 0xffffu)), u3 = gelu_tanh(bf2f(uw.y >> 16));
            o[dg][0] = u0 * (o[dg][0] + bsv); o[dg][1] = u1 * (o[dg][1] + bsv); o[dg][2] = u2 * (o[dg][2] + bsv); o[dg][3] = u3 * (o[dg][3] + bsv); }
        headnorm_store(o, MIX + mytok * DM + 512 + 64 * hh + 4 * fq);
    }
    __syncthreads();
}

__device__ __forceinline__ void addsub_bf16x2(unsigned a, unsigned m, float msk, unsigned& e, unsigned& o) {
    const float al = bf2f(a & 0xffffu), ah = __uint_as_float(a & 0xffff0000u), ml = bf2f(m & 0xffffu), mh = __uint_as_float(m & 0xffff0000u);
    e = cvt_pk_bf16(al + msk * ml, ah + msk * mh); o = cvt_pk_bf16(al - ml, ah - mh);
}
__device__ __forceinline__ void chan_dft(LAS unsigned char* lds, const bf16_t* PROJ, bf16_t* ABT, float* AH, int tid, int gw, int ngw, int lane) {
    const int fr = lane & 15, fq = lane >> 4;
    LAS bf16_t* Ct = (LAS bf16_t*)lds; LAS bf16_t* St = (LAS bf16_t*)(lds + 9216);
    for (int idx = tid; idx < 4096; idx += 512) { const int cp = idx >> 6, c = idx & 63; const float ph = (float)((cp * c) & 63) * (1.0f / 32.0f);
        Ct[cp * 72 + c] = (bf16_t)(cvt_pk_bf16(cospif(ph) * 0.125f, 0.f) & 0xffffu); St[cp * 72 + c] = (bf16_t)(cvt_pk_bf16(sinpif(ph) * 0.125f, 0.f) & 0xffffu); }
    __syncthreads();
#pragma unroll 1
    for (int it = gw; it < NBATCH * 64; it += ngw) { const int b = it >> 6, n0 = (it & 63) * 16; const int np = n0 + fr, mp = (SEQ - np) & (SEQ - 1);
        const float msk = (np == 0) ? 0.f : 1.f; const size_t tokb = (size_t)b * SEQ;
#pragma unroll
        for (int gi = 0; gi < 4; ++gi) {
            const bf16_t* xn = PROJ + (tokb + np) * INW + C_XC + 64 * gi + 8 * fq; const bf16_t* xm = PROJ + (tokb + mp) * INW + C_XC + 64 * gi + 8 * fq;
            const u32x4 a0 = *(const u32x4*)xn, a1 = *(const u32x4*)(xn + 32), m0 = *(const u32x4*)xm, m1 = *(const u32x4*)(xm + 32);
            unsigned ev[8], ov[8];
            addsub_bf16x2(a0.x, m0.x, msk, ev[0], ov[0]); addsub_bf16x2(a0.y, m0.y, msk, ev[1], ov[1]); addsub_bf16x2(a0.z, m0.z, msk, ev[2], ov[2]); addsub_bf16x2(a0.w, m0.w, msk, ev[3], ov[3]);
            addsub_bf16x2(a1.x, m1.x, msk, ev[4], ov[4]); addsub_bf16x2(a1.y, m1.y, msk, ev[5], ov[5]); addsub_bf16x2(a1.z, m1.z, msk, ev[6], ov[6]); addsub_bf16x2(a1.w, m1.w, msk, ev[7], ov[7]);
            const u32x4 e0 = (u32x4){ev[0], ev[1], ev[2], ev[3]}, e1 = (u32x4){ev[4], ev[5], ev[6], ev[7]}, o0 = (u32x4){ov[0], ov[1], ov[2], ov[3]}, o1 = (u32x4){ov[4], ov[5], ov[6], ov[7]};
            const bf16x8 E0 = __builtin_bit_cast(bf16x8, e0), E1 = __builtin_bit_cast(bf16x8, e1), O0 = __builtin_bit_cast(bf16x8, o0), O1 = __builtin_bit_cast(bf16x8, o1);
#pragma unroll
            for (int ct = 0; ct < 4; ++ct) { const int cc = 16 * ct + fr;
                const bf16x8 Bc0 = *(const LAS bf16x8*)(Ct + cc * 72 + 8 * fq), Bc1 = *(const LAS bf16x8*)(Ct + cc * 72 + 32 + 8 * fq);
                const bf16x8 Bs0 = *(const LAS bf16x8*)(St + cc * 72 + 8 * fq), Bs1 = *(const LAS bf16x8*)(St + cc * 72 + 32 + 8 * fq);
                f32x4 aC = (f32x4){0.f, 0.f, 0.f, 0.f}, aS = (f32x4){0.f, 0.f, 0.f, 0.f};
                aC = __builtin_amdgcn_mfma_f32_16x16x32_bf16(E0, Bc0, aC, 0, 0, 0); aC = __builtin_amdgcn_mfma_f32_16x16x32_bf16(E1, Bc1, aC, 0, 0, 0);
                aS = __builtin_amdgcn_mfma_f32_16x16x32_bf16(O0, Bs0, aS, 0, 0, 0); aS = __builtin_amdgcn_mfma_f32_16x16x32_bf16(O1, Bs1, aS, 0, 0, 0);
                const int rho = 128 * (cc >> 5) + 32 * gi + (cc & 31);
                bf16_t* dst = ABT + ((size_t)b * 256 + rho) * 2048 + n0 + 4 * fq;
                u32x2 wc_, ws_; wc_.x = cvt_pk_bf16(aC[0], aC[1]); wc_.y = cvt_pk_bf16(aC[2], aC[3]); ws_.x = cvt_pk_bf16(aS[0], aS[1]); ws_.y = cvt_pk_bf16(aS[2], aS[3]);
                *(u32x2*)dst = wc_; *(u32x2*)(dst + 1024) = ws_; }
            if (n0 == 0) {
                const bf16_t* xh = PROJ + (tokb + 1024) * INW + C_XC + 64 * gi + 8 * fq;
                const bf16x8 H0 = *(const bf16x8*)xh, H1 = *(const bf16x8*)(xh + 32);
#pragma unroll
                for (int ct = 0; ct < 4; ++ct) { const int cc = 16 * ct + fr;
                    const bf16x8 Bc0 = *(const LAS bf16x8*)(Ct + cc * 72 + 8 * fq), Bc1 = *(const LAS bf16x8*)(Ct + cc * 72 + 32 + 8 * fq);
                    f32x4 aH = (f32x4){0.f, 0.f, 0.f, 0.f};
                    aH = __builtin_amdgcn_mfma_f32_16x16x32_bf16(H0, Bc0, aH, 0, 0, 0); aH = __builtin_amdgcn_mfma_f32_16x16x32_bf16(H1, Bc1, aH, 0, 0, 0);
                    if (fq == 0) AH[b * 256 + 128 * (cc >> 5) + 32 * gi + (cc & 31)] = aH[0]; }
            }
        }
    }
    __syncthreads();
}

#define XB_TMO      128
#define XB_XCNT(j)  (256  + 64 * (j))
#define XB_XSUB(j)  (1280 + 64 * (j))
#define XB_XGEN(j)  (2304 + 64 * (j))
#define XB_TOP      3328
#define XB_TOPGEN   3392
#define XCD_BAR_WORDS 3456
#define XB_SPIN_CAP (1u << 18)
__device__ __forceinline__ unsigned xb_ld(unsigned* p)              { return __hip_atomic_load(p, __ATOMIC_RELAXED, __HIP_MEMORY_SCOPE_AGENT); }
__device__ __forceinline__ unsigned xb_add(unsigned* p, unsigned v) { return __hip_atomic_fetch_add(p, v, __ATOMIC_RELAXED, __HIP_MEMORY_SCOPE_AGENT); }
__device__ __forceinline__ unsigned xb_xcc_id() { return (unsigned)__builtin_amdgcn_s_getreg((3 << 11) | 20) & 0xFu; }
#define XB_SPIN(cond, bar) do { unsigned _sp = 0; while (cond) { __builtin_amdgcn_s_sleep(1); \
    if ((++_sp & 255u) == 0u) { if (xb_ld(&(bar)[XB_TMO])) break; if (_sp > XB_SPIN_CAP) { atomicAdd(&(bar)[XB_TMO], 1u); break; } } } } while (0)
struct XcdBarrier { unsigned* bar; unsigned x; volatile LAS unsigned* st; };
__device__ __forceinline__ XcdBarrier xcd_barrier_post(unsigned* bar, volatile LAS unsigned* st) {
    XcdBarrier b; b.bar = bar; b.x = xb_xcc_id(); b.st = st;
    if (threadIdx.x == 0) (void)xb_add(&bar[XB_XCNT(b.x)], 1u);
    return b;
}
__device__ __forceinline__ void xcd_barrier_complete(unsigned* bar, unsigned x, unsigned& nloc, unsigned& nx) {
    const unsigned G = gridDim.x * gridDim.y * gridDim.z;
    unsigned sum, cnt, mine, sp = 0u;
    for (;;) {
        sum = 0u; cnt = 0u; mine = 0u;
#pragma unroll
        for (unsigned j = 0; j < 16; ++j) { const unsigned c = xb_ld(&bar[XB_XCNT(j)]); sum += c; cnt += (c > 0u) ? 1u : 0u; mine = (j == x) ? c : mine; }
        if (sum == G) break;
        __builtin_amdgcn_s_sleep(1);
        if ((++sp & 255u) == 0u) { if (xb_ld(&bar[XB_TMO])) break; if (sp > XB_SPIN_CAP) { atomicAdd(&bar[XB_TMO], 1u); break; } }
    }
    nloc = mine > 0u ? mine : 1u; nx = cnt > 0u ? cnt : 1u;
}
__device__ __forceinline__ void xcd_barrier(const XcdBarrier& b) {
    asm volatile("s_waitcnt vmcnt(0)" ::: "memory");
    __syncthreads();
    if (threadIdx.x == 0) {
        unsigned* bar = b.bar;
        __builtin_amdgcn_s_waitcnt(0);
        unsigned nloc = b.st[0], nx = b.st[1];
        if (nloc == 0u) { xcd_barrier_complete(bar, b.x, nloc, nx); b.st[0] = nloc; b.st[1] = nx; }
        const unsigned old = xb_add(&bar[XB_XSUB(b.x)], 1u);
        const unsigned gen = old / nloc;
        if (old + 1u == (gen + 1u) * nloc) {
            __builtin_amdgcn_fence(__ATOMIC_RELEASE, "agent");
            asm volatile("s_waitcnt vmcnt(0)" ::: "memory");
            const unsigned og = xb_add(&bar[XB_TOP], 1u);
            const unsigned tg = og / nx;
            if (og + 1u == (tg + 1u) * nx) xb_add(&bar[XB_TOPGEN], 1u);
            else XB_SPIN(xb_ld(&bar[XB_TOPGEN]) == tg, bar);
            __builtin_amdgcn_fence(__ATOMIC_ACQUIRE, "agent");
            xb_add(&bar[XB_XGEN(b.x)], 1u);
            asm volatile("s_waitcnt vmcnt(0)" ::: "memory");
        } else {
            XB_SPIN(xb_ld(&bar[XB_XGEN(b.x)]) == gen, bar);
            __builtin_amdgcn_fence(__ATOMIC_ACQUIRE, "agent");
            asm volatile("s_waitcnt vmcnt(0)" ::: "memory");
        }
    }
    __syncthreads();
}
#define GRID_SYNC() xcd_barrier(xbar)

template <int l>
__device__ __forceinline__ void layer_body(const Args& a, LAS unsigned char* lds, const XcdBarrier& xbar) {
    int t_ = threadIdx.x; asm volatile("" : "+v"(t_));
    const int tid = t_, lane = tid & 63, wid = __builtin_amdgcn_readfirstlane(tid >> 6);
    const int G = gridDim.x, bx = blockIdx.x;
    const int gw = bx * 8 + wid, ngw = G * 8;
    unsigned char* ws = a.ws;
    const float* x_in = a.in[0];
    float* out = a.out;
    bf16_t* WIN = (bf16_t*)(ws + WS_WIN); bf16_t* WOUT = (bf16_t*)(ws + WS_WOUT); bf16_t* WGU = (bf16_t*)(ws + WS_WGU); bf16_t* WDN = (bf16_t*)(ws + WS_WDN);
    bf16_t* WSP = (bf16_t*)(ws + WS_WSP); bf16_t* TT = (bf16_t*)(ws + WS_T); u64* RSB = (u64*)(ws + WS_SSQ); u64* RSA = RSB + MTOK; float* AHB = (float*)(ws + WS_SSQ + 2 * MiB);
    bf16_t* XB = (bf16_t*)(ws + WS_XB); bf16_t* ABT = (bf16_t*)(ws + WS_ABT); bf16_t* PROJ = (bf16_t*)(ws + WS_PROJ); bf16_t* MIX = (bf16_t*)(ws + WS_MIX); bf16_t* HID = (bf16_t*)(ws + WS_HID);
        { pg8::Gemm g{XB, WIN + (size_t)l * INW * DM, MTOK, INW, DM}; pg8::StaticOrder S; S.init(MTOK, INW, G, bx);
          pg8::EpiProj E{PROJ, INW, RSB};
          pg8::gemm_phase<pg8::EpiProj, pg8::StaticOrder, true, true>(lds, g, S, E); }
        GRID_SYNC();
        for (int i = bx * 512 + tid; i < 2 * MTOK; i += G * 512) RSB[i] = 0ull;
        for (int it = bx; it < NBATCH * 8; it += G) attn_item(lds, PROJ, MIX, a.in[3] + (size_t)l * 8 * 465, it, tid, wid, lane);
        for (int it = bx; it < NBATCH * 16; it += G) gate_item(lds, PROJ, MIX, a.in[4] + l * 256, a.in[5] + l * 256, WSP + (size_t)l * 4 * 128 * 128, a.in[7] + l * 512, it, wid, lane);
        chan_dft(lds, PROJ, ABT, AHB, tid, gw, ngw, lane);
        GRID_SYNC();
        { pg8::Gemm g{TT, ABT, 2048, 8192, 2048}; pg8::DftOrder S; S.init(G, bx);
          pg8::EpiDft E{MIX, AHB};
          pg8::gemm_phase<pg8::EpiDft, pg8::DftOrder, true, true>(lds, g, S, E); }
        GRID_SYNC();
        { pg8::Gemm g{MIX, WOUT + (size_t)l * DM * DM, MTOK, DM, DM}; pg8::StaticOrder S; S.init(MTOK, DM, G, bx);
          pg8::EpiRes E{XB, RSA};
          pg8::gemm_phase<pg8::EpiRes, pg8::StaticOrder, true, true>(lds, g, S, E); }
        GRID_SYNC();
        { pg8::Gemm g{XB, WGU + (size_t)l * NGU * DM, MTOK, NGU, DM}; pg8::StaticOrder S; S.init(MTOK, NGU, G, bx);
          pg8::EpiGU E{HID, RSA};
          pg8::gemm_phase<pg8::EpiGU, pg8::StaticOrder, true, true>(lds, g, S, E); }
        GRID_SYNC();
        { pg8::Gemm g{HID, WDN + (size_t)l * DM * DFF, MTOK, DM, DFF}; pg8::StaticOrder S; S.init(MTOK, DM, G, bx);
          pg8::EpiRes E{XB, RSB};
          pg8::gemm_phase<pg8::EpiRes, pg8::StaticOrder, true, true>(lds, g, S, E); }
        GRID_SYNC();
}

__global__ void __launch_bounds__(512, 2) fwd_megakernel(Args a) {
    extern __shared__ __attribute__((aligned(16))) unsigned char lds_raw[];
    LAS unsigned char* lds = (LAS unsigned char*)lds_raw;
    cg::grid_group grid = cg::this_grid();
    volatile LAS unsigned* bst = (volatile LAS unsigned*)(lds + LDS_BYTES - 16);
    if (threadIdx.x == 0) { bst[0] = 0u; bst[1] = 0u; }
    __syncthreads();
    const XcdBarrier xbar = xcd_barrier_post((unsigned*)(a.ws + WS_CTL), bst);
    const int tid = threadIdx.x, lane = tid & 63, wid = __builtin_amdgcn_readfirstlane(tid >> 6);
    const int G = gridDim.x, bx = blockIdx.x;
    const int gw = bx * 8 + wid, ngw = G * 8;
    unsigned char* ws = a.ws;
    const float* x_in = a.in[0];
    float* out = a.out;
    bf16_t* WIN = (bf16_t*)(ws + WS_WIN); bf16_t* WOUT = (bf16_t*)(ws + WS_WOUT); bf16_t* WGU = (bf16_t*)(ws + WS_WGU); bf16_t* WDN = (bf16_t*)(ws + WS_WDN);
    bf16_t* WSP = (bf16_t*)(ws + WS_WSP); bf16_t* TT = (bf16_t*)(ws + WS_T); u64* RSB = (u64*)(ws + WS_SSQ); u64* RSA = RSB + MTOK; float* AHB = (float*)(ws + WS_SSQ + 2 * MiB);
    bf16_t* XB = (bf16_t*)(ws + WS_XB); bf16_t* ABT = (bf16_t*)(ws + WS_ABT); bf16_t* PROJ = (bf16_t*)(ws + WS_PROJ); bf16_t* MIX = (bf16_t*)(ws + WS_MIX); bf16_t* HID = (bf16_t*)(ws + WS_HID);

    {
        constexpr int I_IN = 16 * 36, I_OUT = 16 * 16, I_G = 16 * 44, I_D = 44 * 16, I_L = I_IN + I_OUT + 2 * I_G + I_D;
#pragma unroll 1
        for (int it = gw; it < DEPTH * I_L; it += ngw) {
            const int l = it / I_L; int r = it % I_L;
            if (r < I_IN) { const int kb = r / 36, nb = r % 36; transpose_item(a.in[2] + (size_t)l * DM * INW, DM, INW, WIN + (size_t)l * INW * DM, 64 * nb, a.in[1] + l * DM, (64 * nb < 512) ? 0.125f * 1.44269504f : 1.0f, kb, nb, lane); continue; }
            r -= I_IN;
            if (r < I_OUT) { const int kb = r / 16, nb = r % 16; transpose_item(a.in[9] + (size_t)l * DM * DM, DM, DM, WOUT + (size_t)l * DM * DM, 64 * nb, a.in[8] + l * DM, 1.0f, kb, nb, lane); continue; }
            r -= I_OUT;
            if (r < I_G) { const int kb = r / 44, nb = r % 44, n0 = 64 * nb; transpose_item(a.in[11] + (size_t)l * DM * DFF, DM, DFF, WGU + (size_t)l * NGU * DM, (n0 >> 7) * 256 + (n0 & 127), a.in[10] + l * DM, 1.0f, kb, nb, lane); continue; }
            r -= I_G;
            if (r < I_G) { const int kb = r / 44, nb = r % 44, n0 = 64 * nb; transpose_item(a.in[12] + (size_t)l * DM * DFF, DM, DFF, WGU + (size_t)l * NGU * DM, (n0 >> 7) * 256 + 128 + (n0 & 127), a.in[10] + l * DM, 1.0f, kb, nb, lane); continue; }
            r -= I_G;
            { const int kb = r / 16, nb = r % 16; transpose_item(a.in[13] + (size_t)l * DFF * DM, DFF, DM, WDN + (size_t)l * DM * DFF, 64 * nb, nullptr, 1.0f, kb, nb, lane); }
        }
        for (int i = bx * 512 + tid; i < DEPTH * 4 * 128 * 128 / 2; i += G * 512) { const float2 v = ((const float2*)a.in[6])[i]; ((unsigned*)WSP)[i] = cvt_pk_bf16(v.x, v.y); }
#pragma unroll 1
        for (int i = bx * 512 + tid; i < 2048 * 2048 / 8; i += G * 512) { const int k = i >> 8, n8 = (i & 255) * 8; const bool sn = n8 >= 1024; const int nb = n8 & 1023;
            float v[8];
#pragma unroll
            for (int e = 0; e < 8; ++e) { const float ph = (float)((k * (nb + e)) & 2047) * (1.0f / 1024.0f); v[e] = (sn ? -sinpif(ph) : cospif(ph)) * 0.022097086912f; }
            u32x4 w; w.x = cvt_pk_bf16(v[0], v[1]); w.y = cvt_pk_bf16(v[2], v[3]); w.z = cvt_pk_bf16(v[4], v[5]); w.w = cvt_pk_bf16(v[6], v[7]);
            *(u32x4*)(TT + (size_t)k * 2048 + n8) = w; }
#pragma unroll 1
        for (int m0 = gw; m0 < MTOK; m0 += 4 * ngw) { f32x4 v[4][4];
#pragma unroll
            for (int q = 0; q < 4; ++q) { const f32x4* xr = (const f32x4*)(x_in + (size_t)(m0 + q * ngw) * DM) + lane;
#pragma unroll
                for (int jj = 0; jj < 4; ++jj) v[q][jj] = xr[64 * jj]; }
#pragma unroll
            for (int q = 0; q < 4; ++q) { const int m = m0 + q * ngw; float s = 0.f; u32x2* o8 = (u32x2*)(XB + (size_t)m * DM) + lane;
#pragma unroll
                for (int jj = 0; jj < 4; ++jj) { const f32x4 t = v[q][jj]; s += (t[0] * t[0] + t[1] * t[1]) + (t[2] * t[2] + t[3] * t[3]); u32x2 w; w.x = cvt_pk_bf16(t[0], t[1]); w.y = cvt_pk_bf16(t[2], t[3]); o8[64 * jj] = w; }
                s = wave_sum(s);
                if (lane == 0) RSB[m] = (u64)(s * RSS_SCALE); } }
    }
    GRID_SYNC();

    layer_body<0>(a, lds, xbar);
    layer_body<1>(a, lds, xbar); layer_body<2>(a, lds, xbar); layer_body<3>(a, lds, xbar);
    {
        const float* fg = a.in[14];
        f32x4 gv[4];
#pragma unroll
        for (int jj = 0; jj < 4; ++jj) gv[jj] = ((const f32x4*)fg)[lane + 64 * jj];
#pragma unroll 1
        for (int m0 = gw; m0 < MTOK; m0 += 4 * ngw) { u32x2 v[4][4];
#pragma unroll
            for (int q = 0; q < 4; ++q) { const u32x2* xr = (const u32x2*)(XB + (size_t)(m0 + q * ngw) * DM) + lane;
#pragma unroll
                for (int jj = 0; jj < 4; ++jj) v[q][jj] = xr[64 * jj]; }
#pragma unroll
            for (int q = 0; q < 4; ++q) { f32x4* xr = (f32x4*)(out + (size_t)(m0 + q * ngw) * DM) + lane; float s = 0.f; f32x4 t[4];
#pragma unroll
                for (int jj = 0; jj < 4; ++jj) { t[jj] = (f32x4){bf2f(v[q][jj].x & 0xffffu), bf2f(v[q][jj].x >> 16), bf2f(v[q][jj].y & 0xffffu), bf2f(v[q][jj].y >> 16)}; s += (t[jj][0] * t[jj][0] + t[jj][1] * t[jj][1]) + (t[jj][2] * t[jj][2] + t[jj][3] * t[jj][3]); }
                const float rs = rsqrtf(wave_sum(s) * (1.0f / 1024.0f) + EPS);
#pragma unroll
                for (int jj = 0; jj < 4; ++jj) xr[64 * jj] = t[jj] * rs * gv[jj]; } }
    }
    grid.sync();
}

extern "C" void kernel_launch(void* const* d_in, const int* in_sizes, int n_in, void* d_out, int out_size, void* d_ws, size_t ws_size, hipStream_t stream) {
    static int grid = 0;
    if (grid == 0) {
        if (n_in != 15 || in_sizes[0] != MTOK * DM || out_size != MTOK * DM || ws_size < WS_END) { fprintf(stderr, "kernel_launch: unexpected shapes (n_in %d, in0 %d, out %d, ws %zu)\n", n_in, n_in > 0 ? in_sizes[0] : -1, out_size, ws_size); grid = -1; return; }
        int dev = 0, cus = 0, per_cu = 0;
        hipGetDevice(&dev);
        hipDeviceGetAttribute(&cus, hipDeviceAttributeMultiprocessorCount, dev);
        if (hipFuncSetAttribute((const void*)fwd_megakernel, hipFuncAttributeMaxDynamicSharedMemorySize, LDS_BYTES) != hipSuccess) { fprintf(stderr, "kernel_launch: hipFuncSetAttribute(%d B dynamic LDS) failed\n", LDS_BYTES); grid = -1; return; }
        if (hipOccupancyMaxActiveBlocksPerMultiprocessor(&per_cu, (const void*)fwd_megakernel, 512, LDS_BYTES) != hipSuccess || per_cu < 1) { fprintf(stderr, "kernel_launch: occupancy query says %d blocks per CU\n", per_cu); (void)hipGetLastError(); per_cu = 1; }
        grid = cus * per_cu;
        fprintf(stderr, "kernel_launch: grid %d (cus %d x %d)\n", grid, cus, per_cu);
    }
    if (grid < 0) return;
    if (hipMemsetAsync((char*)d_ws + WS_CTL, 0, 16384, stream) != hipSuccess) { fprintf(stderr, "kernel_launch: memset of the barrier word failed\n"); return; }
    Args a{};
    for (int i = 0; i < 15; ++i) a.in[i] = (const float*)d_in[i];
    a.out = (float*)d_out; a.ws = (unsigned char*)d_ws;
    void* args[] = {&a};
    hipError_t e = hipLaunchCooperativeKernel((const void*)fwd_megakernel, dim3(grid), dim3(512), args, LDS_BYTES, stream);
    if (e != hipSuccess) fprintf(stderr, "cooperative launch failed: %s (grid %d)\n", hipGetErrorString(e), grid);
}
```

```cpp
#include <hip/hip_runtime.h>
#include <hip/hip_cooperative_groups.h>
#include <cstdio>
#include <cstdint>
namespace cg = cooperative_groups;

#define LAS __attribute__((address_space(3)))
typedef unsigned short bf16_t;
typedef short bf16x8 __attribute__((ext_vector_type(8)));
typedef float f32x4 __attribute__((ext_vector_type(4)));
typedef unsigned u32x4 __attribute__((ext_vector_type(4)));
typedef unsigned u32x2 __attribute__((ext_vector_type(2)));

constexpr int DM = 1024, NBATCH = 32, SEQ = 2048, DEPTH = 4, MTOK = NBATCH * SEQ;
constexpr int INW = 2304, DFF = 2816, NGU = 2 * DFF;
constexpr int C_Q = 0, C_K = 512, C_V = 1024, C_U = 1536, C_VG = 1792, C_XC = 2048;
constexpr float EPS = 1e-6f;
constexpr int LDS_BYTES = 155648;

constexpr size_t MiB = 1u << 20;
constexpr size_t SZ_WIN = (size_t)INW * DM * 2, SZ_WOUT = (size_t)DM * DM * 2, SZ_WGU = (size_t)NGU * DM * 2, SZ_WDN = (size_t)DM * DFF * 2;
constexpr size_t WS_WIN = 0;
constexpr size_t WS_WOUT = 18 * MiB;
constexpr size_t WS_WGU = 26 * MiB;
constexpr size_t WS_WDN = 70 * MiB;
constexpr size_t WS_WSP = 92 * MiB;
constexpr size_t WS_T = 93 * MiB;
constexpr size_t WS_SSQ = 109 * MiB;
constexpr size_t WS_XB = 113 * MiB;
constexpr size_t WS_ABT = 241 * MiB;
constexpr size_t WS_PROJ = 305 * MiB;
constexpr size_t WS_MIX = 593 * MiB;
constexpr size_t WS_HID = WS_PROJ;
constexpr size_t WS_CTL = 721 * MiB;
constexpr size_t WS_END = 722 * MiB;
static_assert(4 * SZ_WIN <= 18 * MiB && 4 * SZ_WGU <= 44 * MiB && 4 * SZ_WDN <= 22 * MiB && (size_t)MTOK * DFF * 2 <= 416 * MiB, "ws map");

typedef __bf16 bf16v2 __attribute__((ext_vector_type(2)));
typedef float f32v2 __attribute__((ext_vector_type(2)));
__device__ __forceinline__ unsigned cvt_pk_bf16(float lo, float hi) { const f32v2 v = {lo, hi}; const bf16v2 b = __builtin_convertvector(v, bf16v2); return __builtin_bit_cast(unsigned, b); }
__device__ __forceinline__ float bf2f(unsigned h) { return __uint_as_float(h << 16); }
__device__ __forceinline__ float gelu_tanh(float x) { const float t = -2.3022082f * (x + 0.044715f * x * x * x); return x * __builtin_amdgcn_rcpf(1.0f + __builtin_amdgcn_exp2f(t)); }
__device__ __forceinline__ float silu_f(float x) { return x * __builtin_amdgcn_rcpf(1.0f + __builtin_amdgcn_exp2f(-1.44269504f * x)); }
__device__ __forceinline__ float wave_sum(float v) {
#pragma unroll
    for (int o = 1; o < 64; o <<= 1) v += __shfl_xor(v, o);
    return v;
}
typedef unsigned long long u64;
constexpr float RSS_SCALE = 16777216.0f;
__device__ __forceinline__ float row_rs(const u64* rss, int row) { return rsqrtf((float)rss[row] * (1.0f / (RSS_SCALE * 1024.0f)) + EPS); }
__device__ __forceinline__ void headnorm_store(f32x4 (&o)[4], bf16_t* dst) {
    float ss = 0.f;
#pragma unroll
    for (int dg = 0; dg < 4; ++dg) ss += (o[dg][0] * o[dg][0] + o[dg][1] * o[dg][1]) + (o[dg][2] * o[dg][2] + o[dg][3] * o[dg][3]);
    ss += __shfl_xor(ss, 16); ss += __shfl_xor(ss, 32);
    const float sc = rsqrtf(ss * (1.0f / 64.0f) + EPS);
#pragma unroll
    for (int dg = 0; dg < 4; ++dg) { u32x2 w; w.x = cvt_pk_bf16(o[dg][0] * sc, o[dg][1] * sc); w.y = cvt_pk_bf16(o[dg][2] * sc, o[dg][3] * sc); *(u32x2*)(dst + 16 * dg) = w; }
}

namespace pg8 {
constexpr int BM = 256, BK = 64, HALF = 128, HTB = HALF * BK * 2, STAGE_BYTES = 8 * HTB, NXCD = 8, WGM = 8;
__host__ __device__ __forceinline__ int lds_byte(int r, int c) { const int st = (r >> 4) * 2 + (c >> 5), rr = r & 15, cc = c & 31, ob = rr * 64 + cc * 2; return st * 1024 + (ob ^ (((ob >> 9) & 1) << 5)); }
__host__ __device__ __forceinline__ void stage_rc(int b, int& R, int& C) { const int st = b / 1024, sb = b % 1024, swz = sb ^ (((sb >> 9) & 1) << 5); R = (st >> 1) * 16 + swz / 64; C = (st & 1) * 32 + (swz % 64) / 2; }
__host__ __device__ __forceinline__ int perm32(int rho) { const int n = rho >> 4, i = rho & 15; return 8 * (i >> 2) + 4 * n + (i & 3); }

struct Unit { int pm, pn; };
struct Gemm { const bf16_t* A; const bf16_t* Bt; int M, N, K; };

struct StaticOrder {
    int nM, nN, nwg, G, c;
    __device__ void init(int M, int N, int G_, int c_) { nM = M / BM; nN = N / BM; nwg = nM * nN; G = G_; c = c_; }
    __device__ bool next(int i, Unit& u) const {
        const long L = (long)i * G + c; if (L >= nwg) return false;
        int wgid = (int)L; { const int q = nwg / NXCD, r = nwg % NXCD, xcd = wgid % NXCD, off = wgid / NXCD; wgid = (xcd < r ? xcd * (q + 1) : r * (q + 1) + (xcd - r) * q) + off; }
        const int nig = WGM * nN, gid = wgid / nig, fm = gid * WGM, gsz = (nM - fm) < WGM ? (nM - fm) : WGM;
        u.pm = fm + ((wgid % nig) % gsz); u.pn = (wgid % nig) / gsz; return true;
    }
    __device__ __forceinline__ void a_ready(const Unit&) const {}
    __device__ __forceinline__ void done(const Unit&) const {}
};
struct DftOrder {
    int G, c;
    __device__ void init(int G_, int c_) { G = G_; c = c_; }
    __device__ bool next(int i, Unit& u) const {
        const long L = (long)i * G + c; if (L >= 256) return false;
        const int x = (int)L & 7, j = (int)L >> 3; u.pm = j & 7; u.pn = x * 4 + (j >> 3); return true;
    }
    __device__ __forceinline__ void a_ready(const Unit&) const {}
    __device__ __forceinline__ void done(const Unit&) const {}
};

struct EpiProj {
    static constexpr bool PERM = true, AFTER_DRAIN = false;
    bf16_t* O; int ldc; const u64* ssq;
    __device__ __forceinline__ void operator()(const f32x4 (&acc)[2][2][4][2], const Unit& u, int wr, int wc, int fr, int fq) const {
        const int row0 = u.pm * BM + wr * 64 + fr, col0 = u.pn * BM + wc * 32 + 8 * fq;
        float rsv[2][4];
#pragma unroll
        for (int ai = 0; ai < 2; ++ai)
#pragma unroll
            for (int m = 0; m < 4; ++m) rsv[ai][m] = row_rs(ssq, row0 + ai * HALF + m * 16);
#pragma unroll
        for (int ai = 0; ai < 2; ++ai)
#pragma unroll
            for (int m = 0; m < 4; ++m) { const int row = row0 + ai * HALF + m * 16; const float rs = rsv[ai][m]; bf16_t* rowp = O + (size_t)row * ldc + col0;
#pragma unroll
                for (int bj = 0; bj < 2; ++bj) { const f32x4 v0 = acc[ai][bj][m][0] * rs, v1 = acc[ai][bj][m][1] * rs;
                    u32x4 w; w.x = cvt_pk_bf16(v0[0], v0[1]); w.y = cvt_pk_bf16(v0[2], v0[3]); w.z = cvt_pk_bf16(v1[0], v1[1]); w.w = cvt_pk_bf16(v1[2], v1[3]);
                    *(u32x4*)(rowp + bj * HALF) = w; } }
    }
};
struct EpiGU {
    static constexpr bool PERM = true, AFTER_DRAIN = false;
    bf16_t* O; const u64* ssq;
    __device__ __forceinline__ void operator()(const f32x4 (&acc)[2][2][4][2], const Unit& u, int wr, int wc, int fr, int fq) const {
        const int row0 = u.pm * BM + wr * 64 + fr, col0 = u.pn * HALF + wc * 32 + 8 * fq;
        float rsv[2][4];
#pragma unroll
        for (int ai = 0; ai < 2; ++ai)
#pragma unroll
            for (int m = 0; m < 4; ++m) rsv[ai][m] = row_rs(ssq, row0 + ai * HALF + m * 16);
#pragma unroll
        for (int ai = 0; ai < 2; ++ai)
#pragma unroll
            for (int m = 0; m < 4; ++m) { const int row = row0 + ai * HALF + m * 16; const float rs = rsv[ai][m];
                f32x4 h[2];
#pragma unroll
                for (int n = 0; n < 2; ++n) { const f32x4 g = acc[ai][0][m][n] * rs, up = acc[ai][1][m][n] * rs;
#pragma unroll
                    for (int e = 0; e < 4; ++e) h[n][e] = silu_f(g[e]) * up[e]; }
                u32x4 w; w.x = cvt_pk_bf16(h[0][0], h[0][1]); w.y = cvt_pk_bf16(h[0][2], h[0][3]); w.z = cvt_pk_bf16(h[1][0], h[1][1]); w.w = cvt_pk_bf16(h[1][2], h[1][3]);
                *(u32x4*)(O + (size_t)row * DFF + col0) = w; }
    }
};
struct EpiRes {
    static constexpr bool PERM = true, AFTER_DRAIN = false;
    bf16_t* xb; u64* ssq;
    __device__ __forceinline__ void operator()(const f32x4 (&acc)[2][2][4][2], const Unit& u, int wr, int wc, int fr, int fq) const {
        const int row0 = u.pm * BM + wr * 64 + fr, col0 = u.pn * BM + wc * 32 + 8 * fq;
        u32x4 bb[2][2];
#define RES_LOAD(idx) do { const size_t off_ = (size_t)(row0 + ((idx) >> 2) * HALF + ((idx) & 3) * 16) * DM + col0; \
            bb[(idx) & 1][0] = *(const u32x4*)(xb + off_); bb[(idx) & 1][1] = *(const u32x4*)(xb + off_ + HALF); } while (0)
        RES_LOAD(0);
        asm volatile("" ::: "memory");
#pragma unroll
        for (int idx = 0; idx < 8; ++idx) { const int ai = idx >> 2, m = idx & 3; const int row = row0 + ai * HALF + m * 16; const size_t off = (size_t)row * DM + col0; float ss = 0.f;
            if (idx < 7) RES_LOAD(idx + 1);
#pragma unroll
            for (int bj = 0; bj < 2; ++bj) { const u32x4 b = bb[idx & 1][bj];
                const f32x4 r0 = (f32x4){bf2f(b.x & 0xffffu), bf2f(b.x >> 16), bf2f(b.y & 0xffffu), bf2f(b.y >> 16)}, r1 = (f32x4){bf2f(b.z & 0xffffu), bf2f(b.z >> 16), bf2f(b.w & 0xffffu), bf2f(b.w >> 16)};
                const f32x4 v0 = r0 + acc[ai][bj][m][0], v1 = r1 + acc[ai][bj][m][1];
                u32x4 w; w.x = cvt_pk_bf16(v0[0], v0[1]); w.y = cvt_pk_bf16(v0[2], v0[3]); w.z = cvt_pk_bf16(v1[0], v1[1]); w.w = cvt_pk_bf16(v1[2], v1[3]);
                *(u32x4*)(xb + off + bj * HALF) = w;
                ss += (v0[0] * v0[0] + v0[1] * v0[1]) + (v0[2] * v0[2] + v0[3] * v0[3]) + (v1[0] * v1[0] + v1[1] * v1[1]) + (v1[2] * v1[2] + v1[3] * v1[3]); }
            ss += __shfl_xor(ss, 16); ss += __shfl_xor(ss, 32);
            if (fq == 0) (void)__hip_atomic_fetch_add(ssq + row, (u64)(ss * RSS_SCALE), __ATOMIC_RELAXED, __HIP_MEMORY_SCOPE_AGENT);
            asm volatile("" ::: "memory"); }
#undef RES_LOAD
    }
};
struct EpiDft {
    static constexpr bool PERM = true, AFTER_DRAIN = false;
    bf16_t* mix; const float* ah;
    __device__ __forceinline__ void operator()(const f32x4 (&acc)[2][2][4][2], const Unit& u, int wr, int wc, int fr, int fq) const {
        const int row0 = u.pn * SEQ + u.pm * BM + wr * 64 + fr;
        const float sg = (fr & 1) ? -0.022097086912f : 0.022097086912f;
        f32x4 hv[2][2];
#pragma unroll
        for (int bj = 0; bj < 2; ++bj)
#pragma unroll
            for (int n = 0; n < 2; ++n) hv[bj][n] = *(const f32x4*)(ah + u.pn * 256 + 128 * bj + 32 * wc + 8 * fq + 4 * n) * sg;
#pragma unroll
        for (int ai = 0; ai < 2; ++ai)
#pragma unroll
            for (int m = 0; m < 4; ++m) { const int row = row0 + ai * HALF + m * 16; float ss = 0.f; f32x4 v[2][2];
#pragma unroll
                for (int bj = 0; bj < 2; ++bj)
#pragma unroll
                    for (int n = 0; n < 2; ++n) { v[bj][n] = acc[ai][bj][m][n] + hv[bj][n]; ss += (v[bj][n][0] * v[bj][n][0] + v[bj][n][1] * v[bj][n][1]) + (v[bj][n][2] * v[bj][n][2] + v[bj][n][3] * v[bj][n][3]); }
                ss += __shfl_xor(ss, 16); ss += __shfl_xor(ss, 32);
                const float sc = rsqrtf(ss * (1.0f / 64.0f) + EPS);
                bf16_t* rowp = mix + (size_t)row * DM + 768 + 64 * wc + 8 * fq;
#pragma unroll
                for (int bj = 0; bj < 2; ++bj) { const f32x4 v0 = v[bj][0] * sc, v1 = v[bj][1] * sc;
                    u32x4 w; w.x = cvt_pk_bf16(v0[0], v0[1]); w.y = cvt_pk_bf16(v0[2], v0[3]); w.z = cvt_pk_bf16(v1[0], v1[1]); w.w = cvt_pk_bf16(v1[2], v1[3]);
                    *(u32x4*)(rowp + 32 * bj) = w; }
                asm volatile("" ::: "memory"); }
    }
};

template <class Epi, class Sched, bool ALIGN_EPI = false, bool SP2 = false>
__device__ __forceinline__ void gemm_phase(LAS unsigned char* lds, const Gemm g, const Sched& S, const Epi& E) {
    int tid_ = threadIdx.x; asm volatile("" : "+v"(tid_));
    const int tid = tid_, wid = __builtin_amdgcn_readfirstlane(tid >> 6), lane = tid & 63, wr = wid >> 2, wc = wid & 3, fr = lane & 15, fq = lane >> 4;
    const int K = g.K, nt = K / BK;
    unsigned voffA[2], voffB[2];
#pragma unroll
    for (int i = 0; i < 2; ++i) { int R, C; stage_rc(tid * 16 + i * 8192, R, C); const int Rb = Epi::PERM ? ((R & ~31) + perm32(R & 31)) : R;
        voffA[i] = (unsigned)(R * K + C) * 2u; voffB[i] = (unsigned)(Rb * K + C) * 2u; }
    const size_t kstep = (size_t)(BK * 2);
    const size_t hstep = (size_t)HALF * K * 2;
    const size_t tstep = 2 * hstep;
    const unsigned ldsw = (unsigned)wid * 1024u;
    const int aoff = lds_byte(wr * 64 + fr, fq * 8), boff = lds_byte(wc * 32 + fr, fq * 8);
#define PG8_SA(b, h) (((b) * 2 + (h)) * HTB)
#define PG8_SB(b, h) ((4 + (b) * 2 + (h)) * HTB)
#define PG8_STAGE(bufoff, gbase, voff) do { _Pragma("unroll") for (int _i = 0; _i < 2; ++_i) \
        __builtin_amdgcn_global_load_lds((const unsigned*)((const char*)(gbase) + (voff)[_i]), (LAS unsigned*)(lds + (bufoff) + ldsw + _i * 8192), 16, 0, 0); } while (0)
#define PG8_LDA(dst, b, h) do { _Pragma("unroll") for (int m = 0; m < 4; ++m) _Pragma("unroll") for (int k = 0; k < 2; ++k) dst[m][k] = *(const LAS bf16x8*)(lds + PG8_SA(b, h) + aoff + m * 2048 + k * 1024); } while (0)
#define PG8_LDB(dst, b, h) do { _Pragma("unroll") for (int n = 0; n < 2; ++n) _Pragma("unroll") for (int k = 0; k < 2; ++k) dst[n][k] = *(const LAS bf16x8*)(lds + PG8_SB(b, h) + boff + n * 2048 + k * 1024); } while (0)
#define PG8_MMA(ai, bj, At, Bt) do { __builtin_amdgcn_s_setprio(1); _Pragma("unroll") for (int m = 0; m < 4; ++m) _Pragma("unroll") for (int n = 0; n < 2; ++n) _Pragma("unroll") for (int k = 0; k < 2; ++k) \
        acc[ai][bj][m][n] = __builtin_amdgcn_mfma_f32_16x16x32_bf16(Bt[n][k], At[m][k], acc[ai][bj][m][n], 0, 0, 0); __builtin_amdgcn_s_setprio(0); } while (0)
#define PG8_WAIT_V(n) asm volatile("s_waitcnt vmcnt(" #n ")" ::: "memory")
#define PG8_WAIT_L(n) asm volatile("s_waitcnt lgkmcnt(" #n ")" ::: "memory")
#define PG8_BAR __builtin_amdgcn_s_barrier()
#define PG8_SCHED __builtin_amdgcn_sched_barrier(0)
    Unit cur, nxt; int ui = 0;
    if (!S.next(0, cur)) return;
    f32x4 acc[2][2][4][2];
#pragma unroll
    for (int a = 0; a < 2; ++a)
#pragma unroll
        for (int b = 0; b < 2; ++b)
#pragma unroll
            for (int m = 0; m < 4; ++m)
#pragma unroll
                for (int n = 0; n < 2; ++n) acc[a][b][m][n] = (f32x4){0.f, 0.f, 0.f, 0.f};
    bf16x8 At[4][2], B0[2][2], B1[2][2];
    const char* cA = (const char*)g.A + (size_t)cur.pm * tstep; const char* cB = (const char*)g.Bt + (size_t)cur.pn * tstep;
    S.a_ready(cur);
    if constexpr (SP2) {
        PG8_STAGE(PG8_SB(0, 0), cB, voffB); PG8_STAGE(PG8_SB(0, 1), cB + hstep, voffB); PG8_STAGE(PG8_SA(0, 0), cA, voffA); PG8_STAGE(PG8_SA(0, 1), cA + hstep, voffA);
        if (wr == 1) PG8_BAR;
        PG8_WAIT_V(2); PG8_BAR;
        PG8_STAGE(PG8_SB(1, 0), cB + kstep, voffB); PG8_STAGE(PG8_SA(1, 0), cA + kstep, voffA); PG8_STAGE(PG8_SB(1, 1), cB + hstep + kstep, voffB);
        PG8_WAIT_V(6); PG8_BAR;
    } else {
        PG8_STAGE(PG8_SB(0, 0), cB, voffB); PG8_STAGE(PG8_SA(0, 0), cA, voffA); PG8_STAGE(PG8_SB(0, 1), cB + hstep, voffB); PG8_STAGE(PG8_SA(0, 1), cA + hstep, voffA);
        if (wr == 1) PG8_BAR;
        PG8_WAIT_V(4); PG8_BAR;
        PG8_STAGE(PG8_SB(1, 0), cB + kstep, voffB); PG8_STAGE(PG8_SA(1, 0), cA + kstep, voffA); PG8_STAGE(PG8_SB(1, 1), cB + hstep + kstep, voffB);
        PG8_WAIT_V(6); PG8_BAR;
    }
    for (;;) {
        const bool has_next = S.next(ui + 1, nxt);
        const char* nA = has_next ? (const char*)g.A + (size_t)nxt.pm * tstep : cA; const char* nB = has_next ? (const char*)g.Bt + (size_t)nxt.pn * tstep : cB;
        for (int t = 0; t < nt; t += 2) {
            const bool last = (t == nt - 2);
            const char* a1 = cA + (size_t)(t + 1) * kstep;
            const char* a2 = last ? nA : cA + (size_t)(t + 2) * kstep; const char* b2 = last ? nB : cB + (size_t)(t + 2) * kstep;
            const char* a3 = a2 + kstep; const char* b3 = b2 + kstep;
            if (last && has_next) S.a_ready(nxt);
            if constexpr (SP2) {
            PG8_LDB(B0, 0, 0); PG8_LDB(B1, 0, 1); PG8_SCHED; PG8_LDA(At, 0, 0); PG8_STAGE(PG8_SA(1, 1), a1 + hstep, voffA);
            PG8_WAIT_V(8); PG8_WAIT_L(0); PG8_BAR; PG8_MMA(0, 0, At, B0); PG8_MMA(0, 1, At, B1); PG8_BAR; PG8_SCHED;
            PG8_LDA(At, 0, 1); PG8_STAGE(PG8_SB(0, 0), b2, voffB); PG8_STAGE(PG8_SB(0, 1), b2 + hstep, voffB); PG8_STAGE(PG8_SA(0, 0), a2, voffA);
            PG8_WAIT_V(8); PG8_WAIT_L(0); PG8_BAR; PG8_MMA(1, 0, At, B0); PG8_MMA(1, 1, At, B1); PG8_BAR; PG8_SCHED;
            PG8_LDB(B0, 1, 0); PG8_LDB(B1, 1, 1); PG8_SCHED; PG8_LDA(At, 1, 0); PG8_STAGE(PG8_SA(0, 1), a2 + hstep, voffA);
            PG8_WAIT_V(8); PG8_WAIT_L(0); PG8_BAR; PG8_MMA(0, 0, At, B0); PG8_MMA(0, 1, At, B1); PG8_BAR; PG8_SCHED;
            PG8_LDA(At, 1, 1); PG8_STAGE(PG8_SB(1, 0), b3, voffB); PG8_STAGE(PG8_SB(1, 1), b3 + hstep, voffB); PG8_STAGE(PG8_SA(1, 0), a3, voffA);
            PG8_WAIT_V(8); PG8_WAIT_L(0); PG8_BAR; PG8_MMA(1, 0, At, B0); PG8_MMA(1, 1, At, B1); PG8_BAR; PG8_SCHED;
            } else {
            PG8_LDB(B0, 0, 0); PG8_SCHED; PG8_LDA(At, 0, 0); PG8_STAGE(PG8_SA(1, 1), a1 + hstep, voffA);
            PG8_WAIT_L(8); PG8_BAR; PG8_WAIT_L(0); PG8_MMA(0, 0, At, B0); PG8_BAR; PG8_SCHED;
            PG8_LDB(B1, 0, 1); PG8_STAGE(PG8_SB(0, 0), b2, voffB);
            PG8_BAR; PG8_WAIT_L(0); PG8_MMA(0, 1, At, B1); PG8_BAR;
            PG8_LDA(At, 0, 1); PG8_STAGE(PG8_SA(0, 0), a2, voffA);
            PG8_BAR; PG8_WAIT_L(0); PG8_MMA(1, 0, At, B0); PG8_BAR; PG8_SCHED;
            PG8_STAGE(PG8_SB(0, 1), b2 + hstep, voffB);
            PG8_WAIT_V(6); PG8_BAR; PG8_MMA(1, 1, At, B1); PG8_BAR;
            PG8_LDB(B0, 1, 0); PG8_SCHED; PG8_LDA(At, 1, 0); PG8_STAGE(PG8_SA(0, 1), a2 + hstep, voffA);
            PG8_WAIT_L(8); PG8_BAR; PG8_WAIT_L(0); PG8_MMA(0, 0, At, B0); PG8_BAR; PG8_SCHED;
            PG8_LDB(B1, 1, 1); PG8_STAGE(PG8_SB(1, 0), b3, voffB);
            PG8_BAR; PG8_WAIT_L(0); PG8_MMA(0, 1, At, B1); PG8_BAR;
            PG8_LDA(At, 1, 1); PG8_STAGE(PG8_SA(1, 0), a3, voffA);
            PG8_BAR; PG8_WAIT_L(0); PG8_MMA(1, 0, At, B0); PG8_BAR; PG8_SCHED;
            PG8_STAGE(PG8_SB(1, 1), b3 + hstep, voffB);
            PG8_WAIT_V(6); PG8_BAR; PG8_MMA(1, 1, At, B1); PG8_BAR;
            }
        }
        if constexpr (ALIGN_EPI) { if (wr == 0) PG8_BAR; }
        if constexpr (!Epi::AFTER_DRAIN) { E(acc, cur, wr, wc, fr, fq); S.done(cur); }
        if (!has_next) break;
#pragma unroll
        for (int a = 0; a < 2; ++a)
#pragma unroll
            for (int b = 0; b < 2; ++b)
#pragma unroll
                for (int m = 0; m < 4; ++m)
#pragma unroll
                    for (int n = 0; n < 2; ++n) acc[a][b][m][n] = (f32x4){0.f, 0.f, 0.f, 0.f};
        cur = nxt; cA = nA; cB = nB; ++ui;
        if constexpr (ALIGN_EPI) { if (wr == 1) PG8_BAR; }
    }
    PG8_WAIT_V(0);
    if constexpr (!ALIGN_EPI) { if (wr == 0) PG8_BAR; }
    PG8_BAR;
#undef PG8_SA
#undef PG8_SB
#undef PG8_STAGE
#undef PG8_LDA
#undef PG8_LDB
#undef PG8_MMA
#undef PG8_WAIT_V
#undef PG8_WAIT_L
#undef PG8_BAR
#undef PG8_SCHED
}
}

__device__ __forceinline__ void transpose_item(const float* W, int K, int N, bf16_t* WT, int drow0, const float* gk, float cs, int kb, int nb, int lane) {
    const int k0 = 64 * kb, n0 = 64 * nb;
    const float* wp = W + (size_t)k0 * N + n0 + lane;
    float v[64];
#pragma unroll
    for (int j = 0; j < 64; ++j) v[j] = wp[(size_t)j * N];
    bf16_t* op = WT + (size_t)(drow0 + lane) * K + k0;
#pragma unroll
    for (int c = 0; c < 8; ++c) { float t[8];
#pragma unroll
        for (int e = 0; e < 8; ++e) t[e] = v[8 * c + e] * (gk ? gk[k0 + 8 * c + e] * cs : cs);
        u32x4 o; o.x = cvt_pk_bf16(t[0], t[1]); o.y = cvt_pk_bf16(t[2], t[3]); o.z = cvt_pk_bf16(t[4], t[5]); o.w = cvt_pk_bf16(t[6], t[7]);
        *(u32x4*)(op + 8 * c) = o; }
}

struct Args { const float* in[15]; float* out; unsigned char* ws; };

__device__ __forceinline__ void attn_item(LAS unsigned char* lds, const bf16_t* PROJ, bf16_t* MIX, const float* rpb_l, int item, int tid, int wid, int lane) {
    const int b = item >> 3, h = item & 7, fr = lane & 15, fq = lane >> 4;
    LAS unsigned char* Kl = lds; LAS unsigned char* Vl = lds + 73728; LAS float* bias = (LAS float*)(lds + 147456);
    for (int i = tid; i < 480; i += 512) { const int dr_ = i >> 5, dc_ = i & 31; bias[i] = dc_ < 31 ? rpb_l[h * 465 + dr_ * 31 + dc_] * 1.44269504f : -INFINITY; }
    const bf16_t* base = PROJ + (size_t)b * SEQ * INW + h * 64;
    const int lkey = tid >> 2, lcp = tid & 3, lrow = lkey >> 6, lkc = lkey & 63;
    u32x4 kreg0, kreg1, vreg0, vreg1;
    kreg0 = kreg1 = vreg0 = vreg1 = (u32x4){0u, 0u, 0u, 0u};
#define ATT_LOAD(row_lo, cnt) do { if (lrow < (cnt)) { const bf16_t* p_ = base + (size_t)(((row_lo) + lrow) * 64 + lkc) * INW + C_K + lcp * 16; \
        kreg0 = *(const u32x4*)p_; kreg1 = *(const u32x4*)(p_ + 8); vreg0 = *(const u32x4*)(p_ + 512); vreg1 = *(const u32x4*)(p_ + 520); } } while (0)
#define ATT_STORE(row_lo, cnt) do { if (lrow < (cnt)) { const int slot_ = ((row_lo) + lrow) % 9; const int sw_ = (lkc >> 1) & 7; \
        LAS unsigned char* kp_ = Kl + slot_ * 8192 + lkc * 128; \
        *(LAS u32x4*)(kp_ + (((2 * lcp) ^ sw_) << 4)) = kreg0; *(LAS u32x4*)(kp_ + (((2 * lcp + 1) ^ sw_) << 4)) = kreg1; \
        LAS unsigned char* vp_ = Vl + slot_ * 8192 + (lkc & 3) * 2; const int c8_ = lkc >> 2; \
        _Pragma("unroll") for (int e_ = 0; e_ < 8; ++e_) { const int d0_ = lcp * 16 + e_, d1_ = d0_ + 8; \
            const unsigned x0_ = (vreg0[e_ >> 1] >> (16 * (e_ & 1))) & 0xffffu, x1_ = (vreg1[e_ >> 1] >> (16 * (e_ & 1))) & 0xffffu; \
            *(LAS unsigned short*)(vp_ + d0_ * 128 + ((c8_ ^ (((d0_ >> 1) & 7) << 1)) << 3)) = (unsigned short)x0_; \
            *(LAS unsigned short*)(vp_ + d1_ * 128 + ((c8_ ^ (((d1_ >> 1) & 7) << 1)) << 3)) = (unsigned short)x1_; } } } while (0)
    {
        u32x4 ik[4][2], iv[4][2];
#pragma unroll
        for (int q = 0; q < 4; ++q) { const bf16_t* p_ = base + (size_t)((2 * q + lrow) * 64 + lkc) * INW + C_K + lcp * 16;
            ik[q][0] = *(const u32x4*)p_; ik[q][1] = *(const u32x4*)(p_ + 8); iv[q][0] = *(const u32x4*)(p_ + 512); iv[q][1] = *(const u32x4*)(p_ + 520); }
#pragma unroll
        for (int q = 0; q < 4; ++q) { kreg0 = ik[q][0]; kreg1 = ik[q][1]; vreg0 = iv[q][0]; vreg1 = iv[q][1]; ATT_STORE(2 * q, 2); }
    }
    int loaded = 8;
    __syncthreads();
    const int j = wid & 3, bs = min(max(16 * j - 8, 0), 32), qc = 16 * j + fr, wsq = min(max(qc - 8, 0), 48);
    const bf16_t* qbase = PROJ + ((size_t)b * SEQ + (wid >> 2) * 64 + qc) * INW + C_Q + h * 64 + fq * 8;
    bf16x8 bq0 = *(const bf16x8*)qbase, bq1 = *(const bf16x8*)(qbase + 32);
    bool hs[4]; int boff[4];
#pragma unroll
    for (int e = 0; e < 4; ++e) { const int kc0 = bs + 4 * fq + e; hs[e] = !((kc0 >= wsq) && (kc0 < wsq + 16)); boff[e] = ((hs[e] ? kc0 + 16 : kc0) - qc + 15) * 4; }
#pragma unroll 1
    for (int s = 0; s < 16; ++s) {
        const int need_next = (s < 15) ? (min(max(2 * (s + 1) - 3, 0), 24) + 8) : loaded;
        const int cnt = need_next - loaded;
        ATT_LOAD(loaded, cnt);
        {
            const int r = 2 * s + (wid >> 2), rs = min(max(r - 4, 0), 24);
            const size_t qtok = (size_t)b * SEQ + r * 64 + qc;
            const bf16_t* qn = qbase + (size_t)(s < 15 ? s + 1 : s) * 128 * INW;
            const bf16x8 bqn0 = *(const bf16x8*)qn, bqn1 = *(const bf16x8*)(qn + 32);
            f32x4 S[16];
            int slot = rs % 9;
            const int slot0 = slot;
#pragma unroll
            for (int i = 0; i < 8; ++i) {
#pragma unroll
                for (int hf = 0; hf < 2; ++hf) {
                    const int kc = bs + 16 * hf + fr, sw = (kc >> 1) & 7;
                    const LAS unsigned char* kp = Kl + slot * 8192 + kc * 128;
                    const bf16x8 a0 = *(const LAS bf16x8*)(kp + ((fq ^ sw) << 4)), a1 = *(const LAS bf16x8*)(kp + (((fq + 4) ^ sw) << 4));
                    f32x4 acc = (f32x4){0.f, 0.f, 0.f, 0.f};
                    acc = __builtin_amdgcn_mfma_f32_16x16x32_bf16(a0, bq0, acc, 0, 0, 0);
                    acc = __builtin_amdgcn_mfma_f32_16x16x32_bf16(a1, bq1, acc, 0, 0, 0);
                    S[2 * i + hf] = acc;
                }
                slot = (slot == 8) ? 0 : slot + 1;
            }
            float mx = -INFINITY;
            const LAS unsigned char* brow = (const LAS unsigned char*)bias + (rs - r + 7) * 128;
            f32x4 Sv[8];
#pragma unroll
            for (int i = 0; i < 8; ++i)
#pragma unroll
                for (int e = 0; e < 4; ++e) { const float v = (hs[e] ? S[2 * i + 1][e] : S[2 * i][e]) + *(const LAS float*)(brow + i * 128 + boff[e]); Sv[i][e] = v; mx = fmaxf(mx, v); }
            mx = fmaxf(mx, __shfl_xor(mx, 16)); mx = fmaxf(mx, __shfl_xor(mx, 32));
            float l = 0.f;
#pragma unroll
            for (int i = 0; i < 8; ++i)
#pragma unroll
                for (int e = 0; e < 4; ++e) { const float p = __builtin_amdgcn_exp2f(Sv[i][e] - mx); Sv[i][e] = p; l += p; }
            l += __shfl_xor(l, 16); l += __shfl_xor(l, 32);
            f32x4 o[4];
#pragma unroll
            for (int dg = 0; dg < 4; ++dg) o[dg] = (f32x4){0.f, 0.f, 0.f, 0.f};
            slot = slot0;
#pragma unroll
            for (int i = 0; i < 8; ++i) {
                float x0[4], x1[4];
#pragma unroll
                for (int e = 0; e < 4; ++e) { x0[e] = hs[e] ? 0.f : Sv[i][e]; x1[e] = hs[e] ? Sv[i][e] : 0.f; }
                u32x4 pw; pw.x = cvt_pk_bf16(x0[0], x0[1]); pw.y = cvt_pk_bf16(x0[2], x0[3]); pw.z = cvt_pk_bf16(x1[0], x1[1]); pw.w = cvt_pk_bf16(x1[2], x1[3]);
                const bf16x8 pb = __builtin_bit_cast(bf16x8, pw);
#pragma unroll
                for (int dg = 0; dg < 4; ++dg) { const int d = 16 * dg + fr, swv = ((d >> 1) & 7) << 1, cA = (bs >> 2) + fq, cB = cA + 4;
                    const LAS unsigned char* vp = Vl + slot * 8192 + d * 128;
                    const u32x2 lo = *(const LAS u32x2*)(vp + ((cA ^ swv) << 3)), hi = *(const LAS u32x2*)(vp + ((cB ^ swv) << 3));
                    const u32x4 aw = (u32x4){lo.x, lo.y, hi.x, hi.y};
                    o[dg] = __builtin_amdgcn_mfma_f32_16x16x32_bf16(__builtin_bit_cast(bf16x8, aw), pb, o[dg], 0, 0, 0); }
                slot = (slot == 8) ? 0 : slot + 1;
            }
            const float inv = __builtin_amdgcn_rcpf(l);
#pragma unroll
            for (int dg = 0; dg < 4; ++dg) o[dg] = o[dg] * inv;
            headnorm_store(o, MIX + qtok * DM + h * 64 + 4 * fq);
            bq0 = bqn0; bq1 = bqn1;
        }
        __syncthreads();
        ATT_STORE(loaded, cnt); loaded += cnt;
        __syncthreads();
    }
#undef ATT_LOAD
#undef ATT_STORE
}

__device__ __forceinline__ void gate_item(LAS unsigned char* lds, const bf16_t* PROJ, bf16_t* MIX, const float* lng, const float* lnb, const bf16_t* wsb, const float* bsp, int item, int wid, int lane) {
    const int fr = lane & 15, fq = lane >> 4;
    const size_t tok0 = (size_t)item * 128;
    constexpr int PITCH = 272;
    float g4[4], b4[4];
#pragma unroll
    for (int i = 0; i < 4; ++i) { g4[i] = lng[lane + 64 * i]; b4[i] = lnb[lane + 64 * i]; }
#pragma unroll 1
    for (int t0 = 0; t0 < 16; t0 += 4) {
        float v[4][4], s[4], s2[4];
#pragma unroll
        for (int uu = 0; uu < 4; ++uu) { const bf16_t* zp = PROJ + (tok0 + 16 * wid + t0 + uu) * INW + C_VG;
#pragma unroll
            for (int i = 0; i < 4; ++i) v[uu][i] = bf2f(zp[lane + 64 * i]); }
#pragma unroll
        for (int uu = 0; uu < 4; ++uu) { s[uu] = 0.f;
#pragma unroll
            for (int i = 0; i < 4; ++i) { v[uu][i] = gelu_tanh(v[uu][i]); s[uu] += v[uu][i]; } }
#pragma unroll
        for (int o = 1; o < 64; o <<= 1)
#pragma unroll
            for (int uu = 0; uu < 4; ++uu) s[uu] += __shfl_xor(s[uu], o);
#pragma unroll
        for (int uu = 0; uu < 4; ++uu) { const float mean = s[uu] * (1.0f / 256.0f); s2[uu] = 0.f;
#pragma unroll
            for (int i = 0; i < 4; ++i) { v[uu][i] -= mean; s2[uu] += v[uu][i] * v[uu][i]; } }
#pragma unroll
        for (int o = 1; o < 64; o <<= 1)
#pragma unroll
            for (int uu = 0; uu < 4; ++uu) s2[uu] += __shfl_xor(s2[uu], o);
#pragma unroll
        for (int uu = 0; uu < 4; ++uu) { const float rstd = rsqrtf(s2[uu] * (1.0f / 256.0f) + EPS); const int q = 16 * wid + t0 + uu;
#pragma unroll
            for (int i = 0; i < 4; ++i) { const float y = v[uu][i] * rstd * g4[i] + b4[i]; *(LAS unsigned short*)(lds + (lane + 64 * i) * PITCH + q * 2) = (unsigned short)(cvt_pk_bf16(y, 0.f) & 0xffffu); } }
    }
    __syncthreads();
    const int hh = wid >> 1, ph = wid & 1;
#pragma unroll
    for (int pt4 = 0; pt4 < 4; ++pt4) { const int p = 16 * (4 * ph + pt4) + fr;
        bf16x8 B[4];
#pragma unroll
        for (int ks = 0; ks < 4; ++ks) B[ks] = *(const bf16x8*)(wsb + (size_t)(hh * 128 + p) * 128 + 32 * ks + 8 * fq);
        f32x4 o[4];
#pragma unroll
        for (int dg = 0; dg < 4; ++dg) { f32x4 acc = (f32x4){0.f, 0.f, 0.f, 0.f};
#pragma unroll
            for (int ks = 0; ks < 4; ++ks) { const bf16x8 A = *(const LAS bf16x8*)(lds + (64 * hh + 16 * dg + fr) * PITCH + (32 * ks + 8 * fq) * 2); acc = __builtin_amdgcn_mfma_f32_16x16x32_bf16(A, B[ks], acc, 0, 0, 0); }
            o[dg] = acc; }
        const size_t tok = tok0 + (16 * (4 * ph + pt4)) + (lane >> 4) * 0 + 0;
        const size_t mytok = tok + fr;
        const float bsv = bsp[hh * 128 + p];
        const bf16_t* up = PROJ + mytok * INW + C_U + 64 * hh + 4 * fq;
#pragma unroll
        for (int dg = 0; dg < 4; ++dg) { const u32x2 uw = *(const u32x2*)(up + 16 * dg);
            const float u0 = gelu_tanh(bf2f(uw.x & 0xffffu)), u1 = gelu_tanh(bf2f(uw.x >> 16)), u2 = gelu_tanh(bf2f(uw.y & 0xffffu)), u3 = gelu_tanh(bf2f(uw.y >> 16));
            o[dg][0] = u0 * (o[dg][0] + bsv); o[dg][1] = u1 * (o[dg][1] + bsv); o[dg][2] = u2 * (o[dg][2] + bsv); o[dg][3] = u3 * (o[dg][3] + bsv); }
        headnorm_store(o, MIX + mytok * DM + 512 + 64 * hh + 4 * fq);
    }
    __syncthreads();
}

__device__ __forceinline__ void addsub_bf16x2(unsigned a, unsigned m, float msk, unsigned& e, unsigned& o) {
    const float al = bf2f(a & 0xffffu), ah = __uint_as_float(a & 0xffff0000u), ml = bf2f(m & 0xffffu), mh = __uint_as_float(m & 0xffff0000u);
    e = cvt_pk_bf16(al + msk * ml, ah + msk * mh); o = cvt_pk_bf16(al - ml, ah - mh);
}
__device__ __forceinline__ void chan_dft(LAS unsigned char* lds, const bf16_t* PROJ, bf16_t* ABT, float* AH, int tid, int gw, int ngw, int lane) {
    const int fr = lane & 15, fq = lane >> 4;
    LAS bf16_t* Ct = (LAS bf16_t*)lds; LAS bf16_t* St = (LAS bf16_t*)(lds + 9216);
    for (int idx = tid; idx < 4096; idx += 512) { const int cp = idx >> 6, c = idx & 63; const float ph = (float)((cp * c) & 63) * (1.0f / 32.0f);
        Ct[cp * 72 + c] = (bf16_t)(cvt_pk_bf16(cospif(ph) * 0.125f, 0.f) & 0xffffu); St[cp * 72 + c] = (bf16_t)(cvt_pk_bf16(sinpif(ph) * 0.125f, 0.f) & 0xffffu); }
    __syncthreads();
#pragma unroll 1
    for (int it = gw; it < NBATCH * 64; it += ngw) { const int b = it >> 6, n0 = (it & 63) * 16; const int np = n0 + fr, mp = (SEQ - np) & (SEQ - 1);
        const float msk = (np == 0) ? 0.f : 1.f; const size_t tokb = (size_t)b * SEQ;
#pragma unroll
        for (int gi = 0; gi < 4; ++gi) {
            const bf16_t* xn = PROJ + (tokb + np) * INW + C_XC + 64 * gi + 8 * fq; const bf16_t* xm = PROJ + (tokb + mp) * INW + C_XC + 64 * gi + 8 * fq;
            const u32x4 a0 = *(const u32x4*)xn, a1 = *(const u32x4*)(xn + 32), m0 = *(const u32x4*)xm, m1 = *(const u32x4*)(xm + 32);
            unsigned ev[8], ov[8];
            addsub_bf16x2(a0.x, m0.x, msk, ev[0], ov[0]); addsub_bf16x2(a0.y, m0.y, msk, ev[1], ov[1]); addsub_bf16x2(a0.z, m0.z, msk, ev[2], ov[2]); addsub_bf16x2(a0.w, m0.w, msk, ev[3], ov[3]);
            addsub_bf16x2(a1.x, m1.x, msk, ev[4], ov[4]); addsub_bf16x2(a1.y, m1.y, msk, ev[5], ov[5]); addsub_bf16x2(a1.z, m1.z, msk, ev[6], ov[6]); addsub_bf16x2(a1.w, m1.w, msk, ev[7], ov[7]);
            const u32x4 e0 = (u32x4){ev[0], ev[1], ev[2], ev[3]}, e1 = (u32x4){ev[4], ev[5], ev[6], ev[7]}, o0 = (u32x4){ov[0], ov[1], ov[2], ov[3]}, o1 = (u32x4){ov[4], ov[5], ov[6], ov[7]};
            const bf16x8 E0 = __builtin_bit_cast(bf16x8, e0), E1 = __builtin_bit_cast(bf16x8, e1), O0 = __builtin_bit_cast(bf16x8, o0), O1 = __builtin_bit_cast(bf16x8, o1);
#pragma unroll
            for (int ct = 0; ct < 4; ++ct) { const int cc = 16 * ct + fr;
                const bf16x8 Bc0 = *(const LAS bf16x8*)(Ct + cc * 72 + 8 * fq), Bc1 = *(const LAS bf16x8*)(Ct + cc * 72 + 32 + 8 * fq);
                const bf16x8 Bs0 = *(const LAS bf16x8*)(St + cc * 72 + 8 * fq), Bs1 = *(const LAS bf16x8*)(St + cc * 72 + 32 + 8 * fq);
                f32x4 aC = (f32x4){0.f, 0.f, 0.f, 0.f}, aS = (f32x4){0.f, 0.f, 0.f, 0.f};
                aC = __builtin_amdgcn_mfma_f32_16x16x32_bf16(E0, Bc0, aC, 0, 0, 0); aC = __builtin_amdgcn_mfma_f32_16x16x32_bf16(E1, Bc1, aC, 0, 0, 0);
                aS = __builtin_amdgcn_mfma_f32_16x16x32_bf16(O0, Bs0, aS, 0, 0, 0); aS = __builtin_amdgcn_mfma_f32_16x16x32_bf16(O1, Bs1, aS, 0, 0, 0);
                const int rho = 128 * (cc >> 5) + 32 * gi + (cc & 31);
                bf16_t* dst = ABT + ((size_t)b * 256 + rho) * 2048 + n0 + 4 * fq;
                u32x2 wc_, ws_; wc_.x = cvt_pk_bf16(aC[0], aC[1]); wc_.y = cvt_pk_bf16(aC[2], aC[3]); ws_.x = cvt_pk_bf16(aS[0], aS[1]); ws_.y = cvt_pk_bf16(aS[2], aS[3]);
                *(u32x2*)dst = wc_; *(u32x2*)(dst + 1024) = ws_; }
            if (n0 == 0) {
                const bf16_t* xh = PROJ + (tokb + 1024) * INW + C_XC + 64 * gi + 8 * fq;
                const bf16x8 H0 = *(const bf16x8*)xh, H1 = *(const bf16x8*)(xh + 32);
#pragma unroll
                for (int ct = 0; ct < 4; ++ct) { const int cc = 16 * ct + fr;
                    const bf16x8 Bc0 = *(const LAS bf16x8*)(Ct + cc * 72 + 8 * fq), Bc1 = *(const LAS bf16x8*)(Ct + cc * 72 + 32 + 8 * fq);
                    f32x4 aH = (f32x4){0.f, 0.f, 0.f, 0.f};
                    aH = __builtin_amdgcn_mfma_f32_16x16x32_bf16(H0, Bc0, aH, 0, 0, 0); aH = __builtin_amdgcn_mfma_f32_16x16x32_bf16(H1, Bc1, aH, 0, 0, 0);
                    if (fq == 0) AH[b * 256 + 128 * (cc >> 5) + 32 * gi + (cc & 31)] = aH[0]; }
            }
        }
    }
    __syncthreads();
}

#define XB_TMO      128
#define XB_XCNT(j)  (256  + 64 * (j))
#define XB_XSUB(j)  (1280 + 64 * (j))
#define XB_XGEN(j)  (2304 + 64 * (j))
#define XB_TOP      3328
#define XB_TOPGEN   3392
#define XCD_BAR_WORDS 3456
#define XB_SPIN_CAP (1u << 18)
__device__ __forceinline__ unsigned xb_ld(unsigned* p)              { return __hip_atomic_load(p, __ATOMIC_RELAXED, __HIP_MEMORY_SCOPE_AGENT); }
__device__ __forceinline__ unsigned xb_add(unsigned* p, unsigned v) { return __hip_atomic_fetch_add(p, v, __ATOMIC_RELAXED, __HIP_MEMORY_SCOPE_AGENT); }
__device__ __forceinline__ unsigned xb_xcc_id() { return (unsigned)__builtin_amdgcn_s_getreg((3 << 11) | 20) & 0xFu; }
#define XB_SPIN(cond, bar) do { unsigned _sp = 0; while (cond) { __builtin_amdgcn_s_sleep(1); \
    if ((++_sp & 255u) == 0u) { if (xb_ld(&(bar)[XB_TMO])) break; if (_sp > XB_SPIN_CAP) { atomicAdd(&(bar)[XB_TMO], 1u); break; } } } } while (0)
struct XcdBarrier { unsigned* bar; unsigned x; volatile LAS unsigned* st; };
__device__ __forceinline__ XcdBarrier xcd_barrier_post(unsigned* bar, volatile LAS unsigned* st) {
    XcdBarrier b; b.bar = bar; b.x = xb_xcc_id(); b.st = st;
    if (threadIdx.x == 0) (void)xb_add(&bar[XB_XCNT(b.x)], 1u);
    return b;
}
__device__ __forceinline__ void xcd_barrier_complete(unsigned* bar, unsigned x, unsigned& nloc, unsigned& nx) {
    const unsigned G = gridDim.x * gridDim.y * gridDim.z;
    unsigned sum, cnt, mine, sp = 0u;
    for (;;) {
        sum = 0u; cnt = 0u; mine = 0u;
#pragma unroll
        for (unsigned j = 0; j < 16; ++j) { const unsigned c = xb_ld(&bar[XB_XCNT(j)]); sum += c; cnt += (c > 0u) ? 1u : 0u; mine = (j == x) ? c : mine; }
        if (sum == G) break;
        __builtin_amdgcn_s_sleep(1);
        if ((++sp & 255u) == 0u) { if (xb_ld(&bar[XB_TMO])) break; if (sp > XB_SPIN_CAP) { atomicAdd(&bar[XB_TMO], 1u); break; } }
    }
    nloc = mine > 0u ? mine : 1u; nx = cnt > 0u ? cnt : 1u;
}
__device__ __forceinline__ void xcd_barrier(const XcdBarrier& b) {
    asm volatile("s_waitcnt vmcnt(0)" ::: "memory");
    __syncthreads();
    if (threadIdx.x == 0) {
        unsigned* bar = b.bar;
        __builtin_amdgcn_s_waitcnt(0);
        unsigned nloc = b.st[0], nx = b.st[1];
        if (nloc == 0u) { xcd_barrier_complete(bar, b.x, nloc, nx); b.st[0] = nloc; b.st[1] = nx; }
        const unsigned old = xb_add(&bar[XB_XSUB(b.x)], 1u);
        const unsigned gen = old / nloc;
        if (old + 1u == (gen + 1u) * nloc) {
            __builtin_amdgcn_fence(__ATOMIC_RELEASE, "agent");
            asm volatile("s_waitcnt vmcnt(0)" ::: "memory");
            const unsigned og = xb_add(&bar[XB_TOP], 1u);
            const unsigned tg = og / nx;
            if (og + 1u == (tg + 1u) * nx) xb_add(&bar[XB_TOPGEN], 1u);
            else XB_SPIN(xb_ld(&bar[XB_TOPGEN]) == tg, bar);
            __builtin_amdgcn_fence(__ATOMIC_ACQUIRE, "agent");
            xb_add(&bar[XB_XGEN(b.x)], 1u);
            asm volatile("s_waitcnt vmcnt(0)" ::: "memory");
        } else {
            XB_SPIN(xb_ld(&bar[XB_XGEN(b.x)]) == gen, bar);
            __builtin_amdgcn_fence(__ATOMIC_ACQUIRE, "agent");
            asm volatile("s_waitcnt vmcnt(0)" ::: "memory");
        }
    }
    __syncthreads();
}
#define GRID_SYNC() xcd_barrier(xbar)

template <int l>
__device__ __forceinline__ void layer_body(const Args& a, LAS unsigned char* lds, const XcdBarrier& xbar) {
    int t_ = threadIdx.x; asm volatile("" : "+v"(t_));
    const int tid = t_, lane = tid & 63, wid = __builtin_amdgcn_readfirstlane(tid >> 6);
    const int G = gridDim.x, bx = blockIdx.x;
    const int gw = bx * 8 + wid, ngw = G * 8;
    unsigned char* ws = a.ws;
    const float* x_in = a.in[0];
    float* out = a.out;
    bf16_t* WIN = (bf16_t*)(ws + WS_WIN); bf16_t* WOUT = (bf16_t*)(ws + WS_WOUT); bf16_t* WGU = (bf16_t*)(ws + WS_WGU); bf16_t* WDN = (bf16_t*)(ws + WS_WDN);
    bf16_t* WSP = (bf16_t*)(ws + WS_WSP); bf16_t* TT = (bf16_t*)(ws + WS_T); u64* RSB = (u64*)(ws + WS_SSQ); u64* RSA = RSB + MTOK; float* AHB = (float*)(ws + WS_SSQ + 2 * MiB);
    bf16_t* XB = (bf16_t*)(ws + WS_XB); bf16_t* ABT = (bf16_t*)(ws + WS_ABT); bf16_t* PROJ = (bf16_t*)(ws + WS_PROJ); bf16_t* MIX = (bf16_t*)(ws + WS_MIX); bf16_t* HID = (bf16_t*)(ws + WS_HID);
        { pg8::Gemm g{XB, WIN + (size_t)l * INW * DM, MTOK, INW, DM}; pg8::StaticOrder S; S.init(MTOK, INW, G, bx);
          pg8::EpiProj E{PROJ, INW, RSB};
          pg8::gemm_phase<pg8::EpiProj, pg8::StaticOrder, true, true>(lds, g, S, E); }
        GRID_SYNC();
        for (int i = bx * 512 + tid; i < 2 * MTOK; i += G * 512) RSB[i] = 0ull;
        for (int it = bx; it < NBATCH * 8; it += G) attn_item(lds, PROJ, MIX, a.in[3] + (size_t)l * 8 * 465, it, tid, wid, lane);
        for (int it = bx; it < NBATCH * 16; it += G) gate_item(lds, PROJ, MIX, a.in[4] + l * 256, a.in[5] + l * 256, WSP + (size_t)l * 4 * 128 * 128, a.in[7] + l * 512, it, wid, lane);
        chan_dft(lds, PROJ, ABT, AHB, tid, gw, ngw, lane);
        GRID_SYNC();
        { pg8::Gemm g{TT, ABT, 2048, 8192, 2048}; pg8::DftOrder S; S.init(G, bx);
          pg8::EpiDft E{MIX, AHB};
          pg8::gemm_phase<pg8::EpiDft, pg8::DftOrder, true, true>(lds, g, S, E); }
        GRID_SYNC();
        { pg8::Gemm g{MIX, WOUT + (size_t)l * DM * DM, MTOK, DM, DM}; pg8::StaticOrder S; S.init(MTOK, DM, G, bx);
          pg8::EpiRes E{XB, RSA};
          pg8::gemm_phase<pg8::EpiRes, pg8::StaticOrder, true, true>(lds, g, S, E); }
        GRID_SYNC();
        { pg8::Gemm g{XB, WGU + (size_t)l * NGU * DM, MTOK, NGU, DM}; pg8::StaticOrder S; S.init(MTOK, NGU, G, bx);
          pg8::EpiGU E{HID, RSA};
          pg8::gemm_phase<pg8::EpiGU, pg8::StaticOrder, true, true>(lds, g, S, E); }
        GRID_SYNC();
        { pg8::Gemm g{HID, WDN + (size_t)l * DM * DFF, MTOK, DM, DFF}; pg8::StaticOrder S; S.init(MTOK, DM, G, bx);
          pg8::EpiRes E{XB, RSB};
          pg8::gemm_phase<pg8::EpiRes, pg8::StaticOrder, true, true>(lds, g, S, E); }
        GRID_SYNC();
}

__global__ void __launch_bounds__(512, 2) fwd_megakernel(Args a) {
    extern __shared__ __attribute__((aligned(16))) unsigned char lds_raw[];
    LAS unsigned char* lds = (LAS unsigned char*)lds_raw;
    cg::grid_group grid = cg::this_grid();
    volatile LAS unsigned* bst = (volatile LAS unsigned*)(lds + LDS_BYTES - 16);
    if (threadIdx.x == 0) { bst[0] = 0u; bst[1] = 0u; }
    __syncthreads();
    const XcdBarrier xbar = xcd_barrier_post((unsigned*)(a.ws + WS_CTL), bst);
    const int tid = threadIdx.x, lane = tid & 63, wid = __builtin_amdgcn_readfirstlane(tid >> 6);
    const int G = gridDim.x, bx = blockIdx.x;
    const int gw = bx * 8 + wid, ngw = G * 8;
    unsigned char* ws = a.ws;
    const float* x_in = a.in[0];
    float* out = a.out;
    bf16_t* WIN = (bf16_t*)(ws + WS_WIN); bf16_t* WOUT = (bf16_t*)(ws + WS_WOUT); bf16_t* WGU = (bf16_t*)(ws + WS_WGU); bf16_t* WDN = (bf16_t*)(ws + WS_WDN);
    bf16_t* WSP = (bf16_t*)(ws + WS_WSP); bf16_t* TT = (bf16_t*)(ws + WS_T); u64* RSB = (u64*)(ws + WS_SSQ); u64* RSA = RSB + MTOK; float* AHB = (float*)(ws + WS_SSQ + 2 * MiB);
    bf16_t* XB = (bf16_t*)(ws + WS_XB); bf16_t* ABT = (bf16_t*)(ws + WS_ABT); bf16_t* PROJ = (bf16_t*)(ws + WS_PROJ); bf16_t* MIX = (bf16_t*)(ws + WS_MIX); bf16_t* HID = (bf16_t*)(ws + WS_HID);

    {
        constexpr int I_IN = 16 * 36, I_OUT = 16 * 16, I_G = 16 * 44, I_D = 44 * 16, I_L = I_IN + I_OUT + 2 * I_G + I_D;
#pragma unroll 1
        for (int it = gw; it < DEPTH * I_L; it += ngw) {
            const int l = it / I_L; int r = it % I_L;
            if (r < I_IN) { const int kb = r / 36, nb = r % 36; transpose_item(a.in[2] + (size_t)l * DM * INW, DM, INW, WIN + (size_t)l * INW * DM, 64 * nb, a.in[1] + l * DM, (64 * nb < 512) ? 0.125f * 1.44269504f : 1.0f, kb, nb, lane); continue; }
            r -= I_IN;
            if (r < I_OUT) { const int kb = r / 16, nb = r % 16; transpose_item(a.in[9] + (size_t)l * DM * DM, DM, DM, WOUT + (size_t)l * DM * DM, 64 * nb, a.in[8] + l * DM, 1.0f, kb, nb, lane); continue; }
            r -= I_OUT;
            if (r < I_G) { const int kb = r / 44, nb = r % 44, n0 = 64 * nb; transpose_item(a.in[11] + (size_t)l * DM * DFF, DM, DFF, WGU + (size_t)l * NGU * DM, (n0 >> 7) * 256 + (n0 & 127), a.in[10] + l * DM, 1.0f, kb, nb, lane); continue; }
            r -= I_G;
            if (r < I_G) { const int kb = r / 44, nb = r % 44, n0 = 64 * nb; transpose_item(a.in[12] + (size_t)l * DM * DFF, DM, DFF, WGU + (size_t)l * NGU * DM, (n0 >> 7) * 256 + 128 + (n0 & 127), a.in[10] + l * DM, 1.0f, kb, nb, lane); continue; }
            r -= I_G;
            { const int kb = r / 16, nb = r % 16; transpose_item(a.in[13] + (size_t)l * DFF * DM, DFF, DM, WDN + (size_t)l * DM * DFF, 64 * nb, nullptr, 1.0f, kb, nb, lane); }
        }
        for (int i = bx * 512 + tid; i < DEPTH * 4 * 128 * 128 / 2; i += G * 512) { const float2 v = ((const float2*)a.in[6])[i]; ((unsigned*)WSP)[i] = cvt_pk_bf16(v.x, v.y); }
#pragma unroll 1
        for (int i = bx * 512 + tid; i < 2048 * 2048 / 8; i += G * 512) { const int k = i >> 8, n8 = (i & 255) * 8; const bool sn = n8 >= 1024; const int nb = n8 & 1023;
            float v[8];
#pragma unroll
            for (int e = 0; e < 8; ++e) { const float ph = (float)((k * (nb + e)) & 2047) * (1.0f / 1024.0f); v[e] = (sn ? -sinpif(ph) : cospif(ph)) * 0.022097086912f; }
            u32x4 w; w.x = cvt_pk_bf16(v[0], v[1]); w.y = cvt_pk_bf16(v[2], v[3]); w.z = cvt_pk_bf16(v[4], v[5]); w.w = cvt_pk_bf16(v[6], v[7]);
            *(u32x4*)(TT + (size_t)k * 2048 + n8) = w; }
#pragma unroll 1
        for (int m0 = gw; m0 < MTOK; m0 += 4 * ngw) { f32x4 v[4][4];
#pragma unroll
            for (int q = 0; q < 4; ++q) { const f32x4* xr = (const f32x4*)(x_in + (size_t)(m0 + q * ngw) * DM) + lane;
#pragma unroll
                for (int jj = 0; jj < 4; ++jj) v[q][jj] = xr[64 * jj]; }
#pragma unroll
            for (int q = 0; q < 4; ++q) { const int m = m0 + q * ngw; float s = 0.f; u32x2* o8 = (u32x2*)(XB + (size_t)m * DM) + lane;
#pragma unroll
                for (int jj = 0; jj < 4; ++jj) { const f32x4 t = v[q][jj]; s += (t[0] * t[0] + t[1] * t[1]) + (t[2] * t[2] + t[3] * t[3]); u32x2 w; w.x = cvt_pk_bf16(t[0], t[1]); w.y = cvt_pk_bf16(t[2], t[3]); o8[64 * jj] = w; }
                s = wave_sum(s);
                if (lane == 0) RSB[m] = (u64)(s * RSS_SCALE); } }
    }
    GRID_SYNC();

    layer_body<0>(a, lds, xbar);
    layer_body<1>(a, lds, xbar); layer_body<2>(a, lds, xbar); layer_body<3>(a, lds, xbar);
    {
        const float* fg = a.in[14];
        f32x4 gv[4];
#pragma unroll
        for (int jj = 0; jj < 4; ++jj) gv[jj] = ((const f32x4*)fg)[lane + 64 * jj];
#pragma unroll 1
        for (int m0 = gw; m0 < MTOK; m0 += 4 * ngw) { u32x2 v[4][4];
#pragma unroll
            for (int q = 0; q < 4; ++q) { const u32x2* xr = (const u32x2*)(XB + (size_t)(m0 + q * ngw) * DM) + lane;
#pragma unroll
                for (int jj = 0; jj < 4; ++jj) v[q][jj] = xr[64 * jj]; }
#pragma unroll
            for (int q = 0; q < 4; ++q) { f32x4* xr = (f32x4*)(out + (size_t)(m0 + q * ngw) * DM) + lane; float s = 0.f; f32x4 t[4];
#pragma unroll
                for (int jj = 0; jj < 4; ++jj) { t[jj] = (f32x4){bf2f(v[q][jj].x & 0xffffu), bf2f(v[q][jj].x >> 16), bf2f(v[q][jj].y & 0xffffu), bf2f(v[q][jj].y >> 16)}; s += (t[jj][0] * t[jj][0] + t[jj][1] * t[jj][1]) + (t[jj][2] * t[jj][2] + t[jj][3] * t[jj][3]); }
                const float rs = rsqrtf(wave_sum(s) * (1.0f / 1024.0f) + EPS);
#pragma unroll
                for (int jj = 0; jj < 4; ++jj) xr[64 * jj] = t[jj] * rs * gv[jj]; } }
    }
    grid.sync();
}

extern "C" void kernel_launch(void* const* d_in, const int* in_sizes, int n_in, void* d_out, int out_size, void* d_ws, size_t ws_size, hipStream_t stream) {
    static int grid = 0;
    if (grid == 0) {
        if (n_in != 15 || in_sizes[0] != MTOK * DM || out_size != MTOK * DM || ws_size < WS_END) { fprintf(stderr, "kernel_launch: unexpected shapes (n_in %d, in0 %d, out %d, ws %zu)\n", n_in, n_in > 0 ? in_sizes[0] : -1, out_size, ws_size); grid = -1; return; }
        int dev = 0, cus = 0, per_cu = 0;
        hipGetDevice(&dev);
        hipDeviceGetAttribute(&cus, hipDeviceAttributeMultiprocessorCount, dev);
        if (hipFuncSetAttribute((const void*)fwd_megakernel, hipFuncAttributeMaxDynamicSharedMemorySize, LDS_BYTES) != hipSuccess) { fprintf(stderr, "kernel_launch: hipFuncSetAttribute(%d B dynamic LDS) failed\n", LDS_BYTES); grid = -1; return; }
        if (hipOccupancyMaxActiveBlocksPerMultiprocessor(&per_cu, (const void*)fwd_megakernel, 512, LDS_BYTES) != hipSuccess || per_cu < 1) { fprintf(stderr, "kernel_launch: occupancy query says %d blocks per CU\n", per_cu); (void)hipGetLastError(); per_cu = 1; }
        grid = cus * per_cu;
        fprintf(stderr, "kernel_launch: grid %d (cus %d x %d)\n", grid, cus, per_cu);
    }
    if (grid < 0) return;
    if (hipMemsetAsync((char*)d_ws + WS_CTL, 0, 16384, stream) != hipSuccess) { fprintf(stderr, "kernel_launch: memset of the barrier word failed\n"); return; }
    Args a{};
    for (int i = 0; i < 15; ++i) a.in[i] = (const float*)d_in[i];
    a.out = (float*)d_out; a.ws = (unsigned char*)d_ws;
    void* args[] = {&a};
    hipError_t e = hipLaunchCooperativeKernel((const void*)fwd_megakernel, dim3(grid), dim3(512), args, LDS_BYTES, stream);
    if (e != hipSuccess) fprintf(stderr, "cooperative launch failed: %s (grid %d)\n", hipGetErrorString(e), grid);
}
```

```cpp
#include <hip/hip_runtime.h>
#include <hip/hip_cooperative_groups.h>
#include <cstdio>
#include <cstdint>
namespace cg = cooperative_groups;

#define LAS __attribute__((address_space(3)))
typedef unsigned short bf16_t;
typedef short bf16x8 __attribute__((ext_vector_type(8)));
typedef float f32x4 __attribute__((ext_vector_type(4)));
typedef unsigned u32x4 __attribute__((ext_vector_type(4)));
typedef unsigned u32x2 __attribute__((ext_vector_type(2)));

constexpr int DM = 1024, NBATCH = 32, SEQ = 2048, DEPTH = 4, MTOK = NBATCH * SEQ;
constexpr int INW = 2304, DFF = 2816, NGU = 2 * DFF;
constexpr int C_Q = 0, C_K = 512, C_V = 1024, C_U = 1536, C_VG = 1792, C_XC = 2048;
constexpr float EPS = 1e-6f;
constexpr int LDS_BYTES = 155648;

constexpr size_t MiB = 1u << 20;
constexpr size_t SZ_WIN = (size_t)INW * DM * 2, SZ_WOUT = (size_t)DM * DM * 2, SZ_WGU = (size_t)NGU * DM * 2, SZ_WDN = (size_t)DM * DFF * 2;
constexpr size_t WS_WIN = 0;
constexpr size_t WS_WOUT = 18 * MiB;
constexpr size_t WS_WGU = 26 * MiB;
constexpr size_t WS_WDN = 70 * MiB;
constexpr size_t WS_WSP = 92 * MiB;
constexpr size_t WS_T = 93 * MiB;
constexpr size_t WS_SSQ = 109 * MiB;
constexpr size_t WS_XB = 113 * MiB;
constexpr size_t WS_ABT = 241 * MiB;
constexpr size_t WS_PROJ = 305 * MiB;
constexpr size_t WS_MIX = 593 * MiB;
constexpr size_t WS_HID = WS_PROJ;
constexpr size_t WS_CTL = 721 * MiB;
constexpr size_t WS_END = 722 * MiB;
static_assert(4 * SZ_WIN <= 18 * MiB && 4 * SZ_WGU <= 44 * MiB && 4 * SZ_WDN <= 22 * MiB && (size_t)MTOK * DFF * 2 <= 416 * MiB, "ws map");

typedef __bf16 bf16v2 __attribute__((ext_vector_type(2)));
typedef float f32v2 __attribute__((ext_vector_type(2)));
__device__ __forceinline__ unsigned cvt_pk_bf16(float lo, float hi) { const f32v2 v = {lo, hi}; const bf16v2 b = __builtin_convertvector(v, bf16v2); return __builtin_bit_cast(unsigned, b); }
__device__ __forceinline__ float bf2f(unsigned h) { return __uint_as_float(h << 16); }
__device__ __forceinline__ float gelu_tanh(float x) { const float t = -2.3022082f * (x + 0.044715f * x * x * x); return x * __builtin_amdgcn_rcpf(1.0f + __builtin_amdgcn_exp2f(t)); }
__device__ __forceinline__ float silu_f(float x) { return x * __builtin_amdgcn_rcpf(1.0f + __builtin_amdgcn_exp2f(-1.44269504f * x)); }
__device__ __forceinline__ float wave_sum(float v) {
#pragma unroll
    for (int o = 1; o < 64; o <<= 1) v += __shfl_xor(v, o);
    return v;
}
typedef unsigned long long u64;
constexpr float RSS_SCALE = 16777216.0f;
__device__ __forceinline__ float row_rs(const u64* rss, int row) { return rsqrtf((float)rss[row] * (1.0f / (RSS_SCALE * 1024.0f)) + EPS); }
__device__ __forceinline__ void headnorm_store(f32x4 (&o)[4], bf16_t* dst) {
    float ss = 0.f;
#pragma unroll
    for (int dg = 0; dg < 4; ++dg) ss += (o[dg][0] * o[dg][0] + o[dg][1] * o[dg][1]) + (o[dg][2] * o[dg][2] + o[dg][3] * o[dg][3]);
    ss += __shfl_xor(ss, 16); ss += __shfl_xor(ss, 32);
    const float sc = rsqrtf(ss * (1.0f / 64.0f) + EPS);
#pragma unroll
    for (int dg = 0; dg < 4; ++dg) { u32x2 w; w.x = cvt_pk_bf16(o[dg][0] * sc, o[dg][1] * sc); w.y = cvt_pk_bf16(o[dg][2] * sc, o[dg][3] * sc); *(u32x2*)(dst + 16 * dg) = w; }
}

namespace pg8 {
constexpr int BM = 256, BK = 64, HALF = 128, HTB = HALF * BK * 2, STAGE_BYTES = 8 * HTB, NXCD = 8, WGM = 8;
__host__ __device__ __forceinline__ int lds_byte(int r, int c) { const int st = (r >> 4) * 2 + (c >> 5), rr = r & 15, cc = c & 31, ob = rr * 64 + cc * 2; return st * 1024 + (ob ^ (((ob >> 9) & 1) << 5)); }
__host__ __device__ __forceinline__ void stage_rc(int b, int& R, int& C) { const int st = b / 1024, sb = b % 1024, swz = sb ^ (((sb >> 9) & 1) << 5); R = (st >> 1) * 16 + swz / 64; C = (st & 1) * 32 + (swz % 64) / 2; }
__host__ __device__ __forceinline__ int perm32(int rho) { const int n = rho >> 4, i = rho & 15; return 8 * (i >> 2) + 4 * n + (i & 3); }

struct Unit { int pm, pn; };
struct Gemm { const bf16_t* A; const bf16_t* Bt; int M, N, K; };

struct StaticOrder {
    int nM, nN, nwg, G, c;
    __device__ void init(int M, int N, int G_, int c_) { nM = M / BM; nN = N / BM; nwg = nM * nN; G = G_; c = c_; }
    __device__ bool next(int i, Unit& u) const {
        const long L = (long)i * G + c; if (L >= nwg) return false;
        int wgid = (int)L; { const int q = nwg / NXCD, r = nwg % NXCD, xcd = wgid % NXCD, off = wgid / NXCD; wgid = (xcd < r ? xcd * (q + 1) : r * (q + 1) + (xcd - r) * q) + off; }
        const int nig = WGM * nN, gid = wgid / nig, fm = gid * WGM, gsz = (nM - fm) < WGM ? (nM - fm) : WGM;
        u.pm = fm + ((wgid % nig) % gsz); u.pn = (wgid % nig) / gsz; return true;
    }
    __device__ __forceinline__ void a_ready(const Unit&) const {}
    __device__ __forceinline__ void done(const Unit&) const {}
};
struct DftOrder {
    int G, c;
    __device__ void init(int G_, int c_) { G = G_; c = c_; }
    __device__ bool next(int i, Unit& u) const {
        const long L = (long)i * G + c; if (L >= 256) return false;
        const int x = (int)L & 7, j = (int)L >> 3; u.pm = j & 7; u.pn = x * 4 + (j >> 3); return true;
    }
    __device__ __forceinline__ void a_ready(const Unit&) const {}
    __device__ __forceinline__ void done(const Unit&) const {}
};

struct EpiProj {
    static constexpr bool PERM = true, AFTER_DRAIN = false;
    bf16_t* O; int ldc; const u64* ssq;
    __device__ __forceinline__ void operator()(const f32x4 (&acc)[2][2][4][2], const Unit& u, int wr, int wc, int fr, int fq) const {
        const int row0 = u.pm * BM + wr * 64 + fr, col0 = u.pn * BM + wc * 32 + 8 * fq;
        float rsv[2][4];
#pragma unroll
        for (int ai = 0; ai < 2; ++ai)
#pragma unroll
            for (int m = 0; m < 4; ++m) rsv[ai][m] = row_rs(ssq, row0 + ai * HALF + m * 16);
#pragma unroll
        for (int ai = 0; ai < 2; ++ai)
#pragma unroll
            for (int m = 0; m < 4; ++m) { const int row = row0 + ai * HALF + m * 16; const float rs = rsv[ai][m]; bf16_t* rowp = O + (size_t)row * ldc + col0;
#pragma unroll
                for (int bj = 0; bj < 2; ++bj) { const f32x4 v0 = acc[ai][bj][m][0] * rs, v1 = acc[ai][bj][m][1] * rs;
                    u32x4 w; w.x = cvt_pk_bf16(v0[0], v0[1]); w.y = cvt_pk_bf16(v0[2], v0[3]); w.z = cvt_pk_bf16(v1[0], v1[1]); w.w = cvt_pk_bf16(v1[2], v1[3]);
                    *(u32x4*)(rowp + bj * HALF) = w; } }
    }
};
struct EpiGU {
    static constexpr bool PERM = true, AFTER_DRAIN = false;
    bf16_t* O; const u64* ssq;
    __device__ __forceinline__ void operator()(const f32x4 (&acc)[2][2][4][2], const Unit& u, int wr, int wc, int fr, int fq) const {
        const int row0 = u.pm * BM + wr * 64 + fr, col0 = u.pn * HALF + wc * 32 + 8 * fq;
        float rsv[2][4];
#pragma unroll
        for (int ai = 0; ai < 2; ++ai)
#pragma unroll
            for (int m = 0; m < 4; ++m) rsv[ai][m] = row_rs(ssq, row0 + ai * HALF + m * 16);
#pragma unroll
        for (int ai = 0; ai < 2; ++ai)
#pragma unroll
            for (int m = 0; m < 4; ++m) { const int row = row0 + ai * HALF + m * 16; const float rs = rsv[ai][m];
                f32x4 h[2];
#pragma unroll
                for (int n = 0; n < 2; ++n) { const f32x4 g = acc[ai][0][m][n] * rs, up = acc[ai][1][m][n] * rs;
#pragma unroll
                    for (int e = 0; e < 4; ++e) h[n][e] = silu_f(g[e]) * up[e]; }
                u32x4 w; w.x = cvt_pk_bf16(h[0][0], h[0][1]); w.y = cvt_pk_bf16(h[0][2], h[0][3]); w.z = cvt_pk_bf16(h[1][0], h[1][1]); w.w = cvt_pk_bf16(h[1][2], h[1][3]);
                *(u32x4*)(O + (size_t)row * DFF + col0) = w; }
    }
};
struct EpiRes {
    static constexpr bool PERM = true, AFTER_DRAIN = false;
    bf16_t* xb; u64* ssq;
    __device__ __forceinline__ void operator()(const f32x4 (&acc)[2][2][4][2], const Unit& u, int wr, int wc, int fr, int fq) const {
        const int row0 = u.pm * BM + wr * 64 + fr, col0 = u.pn * BM + wc * 32 + 8 * fq;
        u32x4 bb[2][2];
#define RES_LOAD(idx) do { const size_t off_ = (size_t)(row0 + ((idx) >> 2) * HALF + ((idx) & 3) * 16) * DM + col0; \
            bb[(idx) & 1][0] = *(const u32x4*)(xb + off_); bb[(idx) & 1][1] = *(const u32x4*)(xb + off_ + HALF); } while (0)
        RES_LOAD(0);
        asm volatile("" ::: "memory");
#pragma unroll
        for (int idx = 0; idx < 8; ++idx) { const int ai = idx >> 2, m = idx & 3; const int row = row0 + ai * HALF + m * 16; const size_t off = (size_t)row * DM + col0; float ss = 0.f;
            if (idx < 7) RES_LOAD(idx + 1);
#pragma unroll
            for (int bj = 0; bj < 2; ++bj) { const u32x4 b = bb[idx & 1][bj];
                const f32x4 r0 = (f32x4){bf2f(b.x & 0xffffu), bf2f(b.x >> 16), bf2f(b.y & 0xffffu), bf2f(b.y >> 16)}, r1 = (f32x4){bf2f(b.z & 0xffffu), bf2f(b.z >> 16), bf2f(b.w & 0xffffu), bf2f(b.w >> 16)};
                const f32x4 v0 = r0 + acc[ai][bj][m][0], v1 = r1 + acc[ai][bj][m][1];
                u32x4 w; w.x = cvt_pk_bf16(v0[0], v0[1]); w.y = cvt_pk_bf16(v0[2], v0[3]); w.z = cvt_pk_bf16(v1[0], v1[1]); w.w = cvt_pk_bf16(v1[2], v1[3]);
                *(u32x4*)(xb + off + bj * HALF) = w;
                ss += (v0[0] * v0[0] + v0[1] * v0[1]) + (v0[2] * v0[2] + v0[3] * v0[3]) + (v1[0] * v1[0] + v1[1] * v1[1]) + (v1[2] * v1[2] + v1[3] * v1[3]); }
            ss += __shfl_xor(ss, 16); ss += __shfl_xor(ss, 32);
            if (fq == 0) (void)__hip_atomic_fetch_add(ssq + row, (u64)(ss * RSS_SCALE), __ATOMIC_RELAXED, __HIP_MEMORY_SCOPE_AGENT);
            asm volatile("" ::: "memory"); }
#undef RES_LOAD
    }
};
struct EpiDft {
    static constexpr bool PERM = true, AFTER_DRAIN = false;
    bf16_t* mix; const float* ah;
    __device__ __forceinline__ void operator()(const f32x4 (&acc)[2][2][4][2], const Unit& u, int wr, int wc, int fr, int fq) const {
        const int row0 = u.pn * SEQ + u.pm * BM + wr * 64 + fr;
        const float sg = (fr & 1) ? -0.022097086912f : 0.022097086912f;
        f32x4 hv[2][2];
#pragma unroll
        for (int bj = 0; bj < 2; ++bj)
#pragma unroll
            for (int n = 0; n < 2; ++n) hv[bj][n] = *(const f32x4*)(ah + u.pn * 256 + 128 * bj + 32 * wc + 8 * fq + 4 * n) * sg;
#pragma unroll
        for (int ai = 0; ai < 2; ++ai)
#pragma unroll
            for (int m = 0; m < 4; ++m) { const int row = row0 + ai * HALF + m * 16; float ss = 0.f; f32x4 v[2][2];
#pragma unroll
                for (int bj = 0; bj < 2; ++bj)
#pragma unroll
                    for (int n = 0; n < 2; ++n) { v[bj][n] = acc[ai][bj][m][n] + hv[bj][n]; ss += (v[bj][n][0] * v[bj][n][0] + v[bj][n][1] * v[bj][n][1]) + (v[bj][n][2] * v[bj][n][2] + v[bj][n][3] * v[bj][n][3]); }
                ss += __shfl_xor(ss, 16); ss += __shfl_xor(ss, 32);
                const float sc = rsqrtf(ss * (1.0f / 64.0f) + EPS);
                bf16_t* rowp = mix + (size_t)row * DM + 768 + 64 * wc + 8 * fq;
#pragma unroll
                for (int bj = 0; bj < 2; ++bj) { const f32x4 v0 = v[bj][0] * sc, v1 = v[bj][1] * sc;
                    u32x4 w; w.x = cvt_pk_bf16(v0[0], v0[1]); w.y = cvt_pk_bf16(v0[2], v0[3]); w.z = cvt_pk_bf16(v1[0], v1[1]); w.w = cvt_pk_bf16(v1[2], v1[3]);
                    *(u32x4*)(rowp + 32 * bj) = w; }
                asm volatile("" ::: "memory"); }
    }
};

template <class Epi, class Sched, bool ALIGN_EPI = false, bool SP2 = false>
__device__ __forceinline__ void gemm_phase(LAS unsigned char* lds, const Gemm g, const Sched& S, const Epi& E) {
    int tid_ = threadIdx.x; asm volatile("" : "+v"(tid_));
    const int tid = tid_, wid = __builtin_amdgcn_readfirstlane(tid >> 6), lane = tid & 63, wr = wid >> 2, wc = wid & 3, fr = lane & 15, fq = lane >> 4;
    const int K = g.K, nt = K / BK;
    unsigned voffA[2], voffB[2];
#pragma unroll
    for (int i = 0; i < 2; ++i) { int R, C; stage_rc(tid * 16 + i * 8192, R, C); const int Rb = Epi::PERM ? ((R & ~31) + perm32(R & 31)) : R;
        voffA[i] = (unsigned)(R * K + C) * 2u; voffB[i] = (unsigned)(Rb * K + C) * 2u; }
    const size_t kstep = (size_t)(BK * 2);
    const size_t hstep = (size_t)HALF * K * 2;
    const size_t tstep = 2 * hstep;
    const unsigned ldsw = (unsigned)wid * 1024u;
    const int aoff = lds_byte(wr * 64 + fr, fq * 8), boff = lds_byte(wc * 32 + fr, fq * 8);
#define PG8_SA(b, h) (((b) * 2 + (h)) * HTB)
#define PG8_SB(b, h) ((4 + (b) * 2 + (h)) * HTB)
#define PG8_STAGE(bufoff, gbase, voff) do { _Pragma("unroll") for (int _i = 0; _i < 2; ++_i) \
        __builtin_amdgcn_global_load_lds((const unsigned*)((const char*)(gbase) + (voff)[_i]), (LAS unsigned*)(lds + (bufoff) + ldsw + _i * 8192), 16, 0, 0); } while (0)
#define PG8_LDA(dst, b, h) do { _Pragma("unroll") for (int m = 0; m < 4; ++m) _Pragma("unroll") for (int k = 0; k < 2; ++k) dst[m][k] = *(const LAS bf16x8*)(lds + PG8_SA(b, h) + aoff + m * 2048 + k * 1024); } while (0)
#define PG8_LDB(dst, b, h) do { _Pragma("unroll") for (int n = 0; n < 2; ++n) _Pragma("unroll") for (int k = 0; k < 2; ++k) dst[n][k] = *(const LAS bf16x8*)(lds + PG8_SB(b, h) + boff + n * 2048 + k * 1024); } while (0)
#define PG8_MMA(ai, bj, At, Bt) do { __builtin_amdgcn_s_setprio(1); _Pragma("unroll") for (int m = 0; m < 4; ++m) _Pragma("unroll") for (int n = 0; n < 2; ++n) _Pragma("unroll") for (int k = 0; k < 2; ++k) \
        acc[ai][bj][m][n] = __builtin_amdgcn_mfma_f32_16x16x32_bf16(Bt[n][k], At[m][k], acc[ai][bj][m][n], 0, 0, 0); __builtin_amdgcn_s_setprio(0); } while (0)
#define PG8_WAIT_V(n) asm volatile("s_waitcnt vmcnt(" #n ")" ::: "memory")
#define PG8_WAIT_L(n) asm volatile("s_waitcnt lgkmcnt(" #n ")" ::: "memory")
#define PG8_BAR __builtin_amdgcn_s_barrier()
#define PG8_SCHED __builtin_amdgcn_sched_barrier(0)
    Unit cur, nxt; int ui = 0;
    if (!S.next(0, cur)) return;
    f32x4 acc[2][2][4][2];
#pragma unroll
    for (int a = 0; a < 2; ++a)
#pragma unroll
        for (int b = 0; b < 2; ++b)
#pragma unroll
            for (int m = 0; m < 4; ++m)
#pragma unroll
                for (int n = 0; n < 2; ++n) acc[a][b][m][n] = (f32x4){0.f, 0.f, 0.f, 0.f};
    bf16x8 At[4][2], B0[2][2], B1[2][2];
    const char* cA = (const char*)g.A + (size_t)cur.pm * tstep; const char* cB = (const char*)g.Bt + (size_t)cur.pn * tstep;
    S.a_ready(cur);
    if constexpr (SP2) {
        PG8_STAGE(PG8_SB(0, 0), cB, voffB); PG8_STAGE(PG8_SB(0, 1), cB + hstep, voffB); PG8_STAGE(PG8_SA(0, 0), cA, voffA); PG8_STAGE(PG8_SA(0, 1), cA + hstep, voffA);
        if (wr == 1) PG8_BAR;
        PG8_WAIT_V(2); PG8_BAR;
        PG8_STAGE(PG8_SB(1, 0), cB + kstep, voffB); PG8_STAGE(PG8_SA(1, 0), cA + kstep, voffA); PG8_STAGE(PG8_SB(1, 1), cB + hstep + kstep, voffB);
        PG8_WAIT_V(6); PG8_BAR;
    } else {
        PG8_STAGE(PG8_SB(0, 0), cB, voffB); PG8_STAGE(PG8_SA(0, 0), cA, voffA); PG8_STAGE(PG8_SB(0, 1), cB + hstep, voffB); PG8_STAGE(PG8_SA(0, 1), cA + hstep, voffA);
        if (wr == 1) PG8_BAR;
        PG8_WAIT_V(4); PG8_BAR;
        PG8_STAGE(PG8_SB(1, 0), cB + kstep, voffB); PG8_STAGE(PG8_SA(1, 0), cA + kstep, voffA); PG8_STAGE(PG8_SB(1, 1), cB + hstep + kstep, voffB);
        PG8_WAIT_V(6); PG8_BAR;
    }
    for (;;) {
        const bool has_next = S.next(ui + 1, nxt);
        const char* nA = has_next ? (const char*)g.A + (size_t)nxt.pm * tstep : cA; const char* nB = has_next ? (const char*)g.Bt + (size_t)nxt.pn * tstep : cB;
        for (int t = 0; t < nt; t += 2) {
            const bool last = (t == nt - 2);
            const char* a1 = cA + (size_t)(t + 1) * kstep;
            const char* a2 = last ? nA : cA + (size_t)(t + 2) * kstep; const char* b2 = last ? nB : cB + (size_t)(t + 2) * kstep;
            const char* a3 = a2 + kstep; const char* b3 = b2 + kstep;
            if (last && has_next) S.a_ready(nxt);
            if constexpr (SP2) {
            PG8_LDB(B0, 0, 0); PG8_LDB(B1, 0, 1); PG8_SCHED; PG8_LDA(At, 0, 0); PG8_STAGE(PG8_SA(1, 1), a1 + hstep, voffA);
            PG8_WAIT_V(8); PG8_WAIT_L(0); PG8_BAR; PG8_MMA(0, 0, At, B0); PG8_MMA(0, 1, At, B1); PG8_BAR; PG8_SCHED;
            PG8_LDA(At, 0, 1); PG8_STAGE(PG8_SB(0, 0), b2, voffB); PG8_STAGE(PG8_SB(0, 1), b2 + hstep, voffB); PG8_STAGE(PG8_SA(0, 0), a2, voffA);
            PG8_WAIT_V(8); PG8_WAIT_L(0); PG8_BAR; PG8_MMA(1, 0, At, B0); PG8_MMA(1, 1, At, B1); PG8_BAR; PG8_SCHED;
            PG8_LDB(B0, 1, 0); PG8_LDB(B1, 1, 1); PG8_SCHED; PG8_LDA(At, 1, 0); PG8_STAGE(PG8_SA(0, 1), a2 + hstep, voffA);
            PG8_WAIT_V(8); PG8_WAIT_L(0); PG8_BAR; PG8_MMA(0, 0, At, B0); PG8_MMA(0, 1, At, B1); PG8_BAR; PG8_SCHED;
            PG8_LDA(At, 1, 1); PG8_STAGE(PG8_SB(1, 0), b3, voffB); PG8_STAGE(PG8_SB(1, 1), b3 + hstep, voffB); PG8_STAGE(PG8_SA(1, 0), a3, voffA);
            PG8_WAIT_V(8); PG8_WAIT_L(0); PG8_BAR; PG8_MMA(1, 0, At, B0); PG8_MMA(1, 1, At, B1); PG8_BAR; PG8_SCHED;
            } else {
            PG8_LDB(B0, 0, 0); PG8_SCHED; PG8_LDA(At, 0, 0); PG8_STAGE(PG8_SA(1, 1), a1 + hstep, voffA);
            PG8_WAIT_L(8); PG8_BAR; PG8_WAIT_L(0); PG8_MMA(0, 0, At, B0); PG8_BAR; PG8_SCHED;
            PG8_LDB(B1, 0, 1); PG8_STAGE(PG8_SB(0, 0), b2, voffB);
            PG8_BAR; PG8_WAIT_L(0); PG8_MMA(0, 1, At, B1); PG8_BAR;
            PG8_LDA(At, 0, 1); PG8_STAGE(PG8_SA(0, 0), a2, voffA);
            PG8_BAR; PG8_WAIT_L(0); PG8_MMA(1, 0, At, B0); PG8_BAR; PG8_SCHED;
            PG8_STAGE(PG8_SB(0, 1), b2 + hstep, voffB);
            PG8_WAIT_V(6); PG8_BAR; PG8_MMA(1, 1, At, B1); PG8_BAR;
            PG8_LDB(B0, 1, 0); PG8_SCHED; PG8_LDA(At, 1, 0); PG8_STAGE(PG8_SA(0, 1), a2 + hstep, voffA);
            PG8_WAIT_L(8); PG8_BAR; PG8_WAIT_L(0); PG8_MMA(0, 0, At, B0); PG8_BAR; PG8_SCHED;
            PG8_LDB(B1, 1, 1); PG8_STAGE(PG8_SB(1, 0), b3, voffB);
            PG8_BAR; PG8_WAIT_L(0); PG8_MMA(0, 1, At, B1); PG8_BAR;
            PG8_LDA(At, 1, 1); PG8_STAGE(PG8_SA(1, 0), a3, voffA);
            PG8_BAR; PG8_WAIT_L(0); PG8_MMA(1, 0, At, B0); PG8_BAR; PG8_SCHED;
            PG8_STAGE(PG8_SB(1, 1), b3 + hstep, voffB);
            PG8_WAIT_V(6); PG8_BAR; PG8_MMA(1, 1, At, B1); PG8_BAR;
            }
        }
        if constexpr (ALIGN_EPI) { if (wr == 0) PG8_BAR; }
        if constexpr (!Epi::AFTER_DRAIN) { E(acc, cur, wr, wc, fr, fq); S.done(cur); }
        if (!has_next) break;
#pragma unroll
        for (int a = 0; a < 2; ++a)
#pragma unroll
            for (int b = 0; b < 2; ++b)
#pragma unroll
                for (int m = 0; m < 4; ++m)
#pragma unroll
                    for (int n = 0; n < 2; ++n) acc[a][b][m][n] = (f32x4){0.f, 0.f, 0.f, 0.f};
        cur = nxt; cA = nA; cB = nB; ++ui;
        if constexpr (ALIGN_EPI) { if (wr == 1) PG8_BAR; }
    }
    PG8_WAIT_V(0);
    if constexpr (!ALIGN_EPI) { if (wr == 0) PG8_BAR; }
    PG8_BAR;
#undef PG8_SA
#undef PG8_SB
#undef PG8_STAGE
#undef PG8_LDA
#undef PG8_LDB
#undef PG8_MMA
#undef PG8_WAIT_V
#undef PG8_WAIT_L
#undef PG8_BAR
#undef PG8_SCHED
}
}

__device__ __forceinline__ void transpose_item(const float* W, int K, int N, bf16_t* WT, int drow0, const float* gk, float cs, int kb, int nb, int lane) {
    const int k0 = 64 * kb, n0 = 64 * nb;
    const float* wp = W + (size_t)k0 * N + n0 + lane;
    float v[64];
#pragma unroll
    for (int j = 0; j < 64; ++j) v[j] = wp[(size_t)j * N];
    bf16_t* op = WT + (size_t)(drow0 + lane) * K + k0;
#pragma unroll
    for (int c = 0; c < 8; ++c) { float t[8];
#pragma unroll
        for (int e = 0; e < 8; ++e) t[e] = v[8 * c + e] * (gk ? gk[k0 + 8 * c + e] * cs : cs);
        u32x4 o; o.x = cvt_pk_bf16(t[0], t[1]); o.y = cvt_pk_bf16(t[2], t[3]); o.z = cvt_pk_bf16(t[4], t[5]); o.w = cvt_pk_bf16(t[6], t[7]);
        *(u32x4*)(op + 8 * c) = o; }
}

struct Args { const float* in[15]; float* out; unsigned char* ws; };

__device__ __forceinline__ void attn_item(LAS unsigned char* lds, const bf16_t* PROJ, bf16_t* MIX, const float* rpb_l, int item, int tid, int wid, int lane) {
    const int b = item >> 3, h = item & 7, fr = lane & 15, fq = lane >> 4;
    LAS unsigned char* Kl = lds; LAS unsigned char* Vl = lds + 73728; LAS float* bias = (LAS float*)(lds + 147456);
    for (int i = tid; i < 480; i += 512) { const int dr_ = i >> 5, dc_ = i & 31; bias[i] = dc_ < 31 ? rpb_l[h * 465 + dr_ * 31 + dc_] * 1.44269504f : -INFINITY; }
    const bf16_t* base = PROJ + (size_t)b * SEQ * INW + h * 64;
    const int lkey = tid >> 2, lcp = tid & 3, lrow = lkey >> 6, lkc = lkey & 63;
    u32x4 kreg0, kreg1, vreg0, vreg1;
    kreg0 = kreg1 = vreg0 = vreg1 = (u32x4){0u, 0u, 0u, 0u};
#define ATT_LOAD(row_lo, cnt) do { if (lrow < (cnt)) { const bf16_t* p_ = base + (size_t)(((row_lo) + lrow) * 64 + lkc) * INW + C_K + lcp * 16; \
        kreg0 = *(const u32x4*)p_; kreg1 = *(const u32x4*)(p_ + 8); vreg0 = *(const u32x4*)(p_ + 512); vreg1 = *(const u32x4*)(p_ + 520); } } while (0)
#define ATT_STORE(row_lo, cnt) do { if (lrow < (cnt)) { const int slot_ = ((row_lo) + lrow) % 9; const int sw_ = (lkc >> 1) & 7; \
        LAS unsigned char* kp_ = Kl + slot_ * 8192 + lkc * 128; \
        *(LAS u32x4*)(kp_ + (((2 * lcp) ^ sw_) << 4)) = kreg0; *(LAS u32x4*)(kp_ + (((2 * lcp + 1) ^ sw_) << 4)) = kreg1; \
        LAS unsigned char* vp_ = Vl + slot_ * 8192 + (lkc & 3) * 2; const int c8_ = lkc >> 2; \
        _Pragma("unroll") for (int e_ = 0; e_ < 8; ++e_) { const int d0_ = lcp * 16 + e_, d1_ = d0_ + 8; \
            const unsigned x0_ = (vreg0[e_ >> 1] >> (16 * (e_ & 1))) & 0xffffu, x1_ = (vreg1[e_ >> 1] >> (16 * (e_ & 1))) & 0xffffu; \
            *(LAS unsigned short*)(vp_ + d0_ * 128 + ((c8_ ^ (((d0_ >> 1) & 7) << 1)) << 3)) = (unsigned short)x0_; \
            *(LAS unsigned short*)(vp_ + d1_ * 128 + ((c8_ ^ (((d1_ >> 1) & 7) << 1)) << 3)) = (unsigned short)x1_; } } } while (0)
    {
        u32x4 ik[4][2], iv[4][2];
#pragma unroll
        for (int q = 0; q < 4; ++q) { const bf16_t* p_ = base + (size_t)((2 * q + lrow) * 64 + lkc) * INW + C_K + lcp * 16;
            ik[q][0] = *(const u32x4*)p_; ik[q][1] = *(const u32x4*)(p_ + 8); iv[q][0] = *(const u32x4*)(p_ + 512); iv[q][1] = *(const u32x4*)(p_ + 520); }
#pragma unroll
        for (int q = 0; q < 4; ++q) { kreg0 = ik[q][0]; kreg1 = ik[q][1]; vreg0 = iv[q][0]; vreg1 = iv[q][1]; ATT_STORE(2 * q, 2); }
    }
    int loaded = 8;
    __syncthreads();
    const int j = wid & 3, bs = min(max(16 * j - 8, 0), 32), qc = 16 * j + fr, wsq = min(max(qc - 8, 0), 48);
    const bf16_t* qbase = PROJ + ((size_t)b * SEQ + (wid >> 2) * 64 + qc) * INW + C_Q + h * 64 + fq * 8;
    bf16x8 bq0 = *(const bf16x8*)qbase, bq1 = *(const bf16x8*)(qbase + 32);
    bool hs[4]; int boff[4];
#pragma unroll
    for (int e = 0; e < 4; ++e) { const int kc0 = bs + 4 * fq + e; hs[e] = !((kc0 >= wsq) && (kc0 < wsq + 16)); boff[e] = ((hs[e] ? kc0 + 16 : kc0) - qc + 15) * 4; }
#pragma unroll 1
    for (int s = 0; s < 16; ++s) {
        const int need_next = (s < 15) ? (min(max(2 * (s + 1) - 3, 0), 24) + 8) : loaded;
        const int cnt = need_next - loaded;
        ATT_LOAD(loaded, cnt);
        {
            const int r = 2 * s + (wid >> 2), rs = min(max(r - 4, 0), 24);
            const size_t qtok = (size_t)b * SEQ + r * 64 + qc;
            const bf16_t* qn = qbase + (size_t)(s < 15 ? s + 1 : s) * 128 * INW;
            const bf16x8 bqn0 = *(const bf16x8*)qn, bqn1 = *(const bf16x8*)(qn + 32);
            f32x4 S[16];
            int slot = rs % 9;
            const int slot0 = slot;
#pragma unroll
            for (int i = 0; i < 8; ++i) {
#pragma unroll
                for (int hf = 0; hf < 2; ++hf) {
                    const int kc = bs + 16 * hf + fr, sw = (kc >> 1) & 7;
                    const LAS unsigned char* kp = Kl + slot * 8192 + kc * 128;
                    const bf16x8 a0 = *(const LAS bf16x8*)(kp + ((fq ^ sw) << 4)), a1 = *(const LAS bf16x8*)(kp + (((fq + 4) ^ sw) << 4));
                    f32x4 acc = (f32x4){0.f, 0.f, 0.f, 0.f};
                    acc = __builtin_amdgcn_mfma_f32_16x16x32_bf16(a0, bq0, acc, 0, 0, 0);
                    acc = __builtin_amdgcn_mfma_f32_16x16x32_bf16(a1, bq1, acc, 0, 0, 0);
                    S[2 * i + hf] = acc;
                }
                slot = (slot == 8) ? 0 : slot + 1;
            }
            float mx = -INFINITY;
            const LAS unsigned char* brow = (const LAS unsigned char*)bias + (rs - r + 7) * 128;
            f32x4 Sv[8];
#pragma unroll
            for (int i = 0; i < 8; ++i)
#pragma unroll
                for (int e = 0; e < 4; ++e) { const float v = (hs[e] ? S[2 * i + 1][e] : S[2 * i][e]) + *(const LAS float*)(brow + i * 128 + boff[e]); Sv[i][e] = v; mx = fmaxf(mx, v); }
            mx = fmaxf(mx, __shfl_xor(mx, 16)); mx = fmaxf(mx, __shfl_xor(mx, 32));
            float l = 0.f;
#pragma unroll
            for (int i = 0; i < 8; ++i)
#pragma unroll
                for (int e = 0; e < 4; ++e) { const float p = __builtin_amdgcn_exp2f(Sv[i][e] - mx); Sv[i][e] = p; l += p; }
            l += __shfl_xor(l, 16); l += __shfl_xor(l, 32);
            f32x4 o[4];
#pragma unroll
            for (int dg = 0; dg < 4; ++dg) o[dg] = (f32x4){0.f, 0.f, 0.f, 0.f};
            slot = slot0;
#pragma unroll
            for (int i = 0; i < 8; ++i) {
                float x0[4], x1[4];
#pragma unroll
                for (int e = 0; e < 4; ++e) { x0[e] = hs[e] ? 0.f : Sv[i][e]; x1[e] = hs[e] ? Sv[i][e] : 0.f; }
                u32x4 pw; pw.x = cvt_pk_bf16(x0[0], x0[1]); pw.y = cvt_pk_bf16(x0[2], x0[3]); pw.z = cvt_pk_bf16(x1[0], x1[1]); pw.w = cvt_pk_bf16(x1[2], x1[3]);
                const bf16x8 pb = __builtin_bit_cast(bf16x8, pw);
#pragma unroll
                for (int dg = 0; dg < 4; ++dg) { const int d = 16 * dg + fr, swv = ((d >> 1) & 7) << 1, cA = (bs >> 2) + fq, cB = cA + 4;
                    const LAS unsigned char* vp = Vl + slot * 8192 + d * 128;
                    const u32x2 lo = *(const LAS u32x2*)(vp + ((cA ^ swv) << 3)), hi = *(const LAS u32x2*)(vp + ((cB ^ swv) << 3));
                    const u32x4 aw = (u32x4){lo.x, lo.y, hi.x, hi.y};
                    o[dg] = __builtin_amdgcn_mfma_f32_16x16x32_bf16(__builtin_bit_cast(bf16x8, aw), pb, o[dg], 0, 0, 0); }
                slot = (slot == 8) ? 0 : slot + 1;
            }
            const float inv = __builtin_amdgcn_rcpf(l);
#pragma unroll
            for (int dg = 0; dg < 4; ++dg) o[dg] = o[dg] * inv;
            headnorm_store(o, MIX + qtok * DM + h * 64 + 4 * fq);
            bq0 = bqn0; bq1 = bqn1;
        }
        __syncthreads();
        ATT_STORE(loaded, cnt); loaded += cnt;
        __syncthreads();
    }
#undef ATT_LOAD
#undef ATT_STORE
}

__device__ __forceinline__ void gate_item(LAS unsigned char* lds, const bf16_t* PROJ, bf16_t* MIX, const float* lng, const float* lnb, const bf16_t* wsb, const float* bsp, int item, int wid, int lane) {
    const int fr = lane & 15, fq = lane >> 4;
    const size_t tok0 = (size_t)item * 128;
    constexpr int PITCH = 272;
    float g4[4], b4[4];
#pragma unroll
    for (int i = 0; i < 4; ++i) { g4[i] = lng[lane + 64 * i]; b4[i] = lnb[lane + 64 * i]; }
    float raw[16][4];
#pragma unroll
    for (int tt = 0; tt < 16; ++tt) { const bf16_t* zp = PROJ + (tok0 + 16 * wid + tt) * INW + C_VG;
#pragma unroll
        for (int i = 0; i < 4; ++i) raw[tt][i] = bf2f(zp[lane + 64 * i]); }
#pragma unroll
    for (int t0 = 0; t0 < 16; t0 += 4) {
        float v[4][4], s[4], s2[4];
#pragma unroll
        for (int uu = 0; uu < 4; ++uu)
#pragma unroll
            for (int i = 0; i < 4; ++i) v[uu][i] = raw[t0 + uu][i];
#pragma unroll
        for (int uu = 0; uu < 4; ++uu) { s[uu] = 0.f;
#pragma unroll
            for (int i = 0; i < 4; ++i) { v[uu][i] = gelu_tanh(v[uu][i]); s[uu] += v[uu][i]; } }
#pragma unroll
        for (int o = 1; o < 64; o <<= 1)
#pragma unroll
            for (int uu = 0; uu < 4; ++uu) s[uu] += __shfl_xor(s[uu], o);
#pragma unroll
        for (int uu = 0; uu < 4; ++uu) { const float mean = s[uu] * (1.0f / 256.0f); s2[uu] = 0.f;
#pragma unroll
            for (int i = 0; i < 4; ++i) { v[uu][i] -= mean; s2[uu] += v[uu][i] * v[uu][i]; } }
#pragma unroll
        for (int o = 1; o < 64; o <<= 1)
#pragma unroll
            for (int uu = 0; uu < 4; ++uu) s2[uu] += __shfl_xor(s2[uu], o);
#pragma unroll
        for (int uu = 0; uu < 4; ++uu) { const float rstd = rsqrtf(s2[uu] * (1.0f / 256.0f) + EPS); const int q = 16 * wid + t0 + uu;
#pragma unroll
            for (int i = 0; i < 4; ++i) { const float y = v[uu][i] * rstd * g4[i] + b4[i]; *(LAS unsigned short*)(lds + (lane + 64 * i) * PITCH + q * 2) = (unsigned short)(cvt_pk_bf16(y, 0.f) & 0xffffu); } }
    }
    __syncthreads();
    const int hh = wid >> 1, ph = wid & 1;
#pragma unroll
    for (int pt4 = 0; pt4 < 4; ++pt4) { const int p = 16 * (4 * ph + pt4) + fr;
        bf16x8 B[4];
#pragma unroll
        for (int ks = 0; ks < 4; ++ks) B[ks] = *(const bf16x8*)(wsb + (size_t)(hh * 128 + p) * 128 + 32 * ks + 8 * fq);
        f32x4 o[4];
#pragma unroll
        for (int dg = 0; dg < 4; ++dg) { f32x4 acc = (f32x4){0.f, 0.f, 0.f, 0.f};
#pragma unroll
            for (int ks = 0; ks < 4; ++ks) { const bf16x8 A = *(const LAS bf16x8*)(lds + (64 * hh + 16 * dg + fr) * PITCH + (32 * ks + 8 * fq) * 2); acc = __builtin_amdgcn_mfma_f32_16x16x32_bf16(A, B[ks], acc, 0, 0, 0); }
            o[dg] = acc; }
        const size_t tok = tok0 + (16 * (4 * ph + pt4)) + (lane >> 4) * 0 + 0;
        const size_t mytok = tok + fr;
        const float bsv = bsp[hh * 128 + p];
        const bf16_t* up = PROJ + mytok * INW + C_U + 64 * hh + 4 * fq;
#pragma unroll
        for (int dg = 0; dg < 4; ++dg) { const u32x2 uw = *(const u32x2*)(up + 16 * dg);
            const float u0 = gelu_tanh(bf2f(uw.x & 0xffffu)), u1 = gelu_tanh(bf2f(uw.x >> 16)), u2 = gelu_tanh(bf2f(uw.y & 0xffffu)), u3 = gelu_tanh(bf2f(uw.y >> 16));
            o[dg][0] = u0 * (o[dg][0] + bsv); o[dg][1] = u1 * (o[dg][1] + bsv); o[dg][2] = u2 * (o[dg][2] + bsv); o[dg][3] = u3 * (o[dg][3] + bsv); }
        headnorm_store(o, MIX + mytok * DM + 512 + 64 * hh + 4 * fq);
    }
    __syncthreads();
}

__device__ __forceinline__ void addsub_bf16x2(unsigned a, unsigned m, float msk, unsigned& e, unsigned& o) {
    const float al = bf2f(a & 0xffffu), ah = __uint_as_float(a & 0xffff0000u), ml = bf2f(m & 0xffffu), mh = __uint_as_float(m & 0xffff0000u);
    e = cvt_pk_bf16(al + msk * ml, ah + msk * mh); o = cvt_pk_bf16(al - ml, ah - mh);
}
__device__ __forceinline__ void chan_dft(LAS unsigned char* lds, const bf16_t* PROJ, bf16_t* ABT, float* AH, int tid, int gw, int ngw, int lane) {
    const int fr = lane & 15, fq = lane >> 4;
    LAS bf16_t* Ct = (LAS bf16_t*)lds; LAS bf16_t* St = (LAS bf16_t*)(lds + 9216);
    for (int idx = tid; idx < 4096; idx += 512) { const int cp = idx >> 6, c = idx & 63; const float ph = (float)((cp * c) & 63) * (1.0f / 32.0f);
        Ct[cp * 72 + c] = (bf16_t)(cvt_pk_bf16(cospif(ph) * 0.125f, 0.f) & 0xffffu); St[cp * 72 + c] = (bf16_t)(cvt_pk_bf16(sinpif(ph) * 0.125f, 0.f) & 0xffffu); }
    __syncthreads();
#pragma unroll 1
    for (int it = gw; it < NBATCH * 64; it += ngw) { const int b = it >> 6, n0 = (it & 63) * 16; const int np = n0 + fr, mp = (SEQ - np) & (SEQ - 1);
        const float msk = (np == 0) ? 0.f : 1.f; const size_t tokb = (size_t)b * SEQ;
#pragma unroll
        for (int gi = 0; gi < 4; ++gi) {
            const bf16_t* xn = PROJ + (tokb + np) * INW + C_XC + 64 * gi + 8 * fq; const bf16_t* xm = PROJ + (tokb + mp) * INW + C_XC + 64 * gi + 8 * fq;
            const u32x4 a0 = *(const u32x4*)xn, a1 = *(const u32x4*)(xn + 32), m0 = *(const u32x4*)xm, m1 = *(const u32x4*)(xm + 32);
            unsigned ev[8], ov[8];
            addsub_bf16x2(a0.x, m0.x, msk, ev[0], ov[0]); addsub_bf16x2(a0.y, m0.y, msk, ev[1], ov[1]); addsub_bf16x2(a0.z, m0.z, msk, ev[2], ov[2]); addsub_bf16x2(a0.w, m0.w, msk, ev[3], ov[3]);
            addsub_bf16x2(a1.x, m1.x, msk, ev[4], ov[4]); addsub_bf16x2(a1.y, m1.y, msk, ev[5], ov[5]); addsub_bf16x2(a1.z, m1.z, msk, ev[6], ov[6]); addsub_bf16x2(a1.w, m1.w, msk, ev[7], ov[7]);
            const u32x4 e0 = (u32x4){ev[0], ev[1], ev[2], ev[3]}, e1 = (u32x4){ev[4], ev[5], ev[6], ev[7]}, o0 = (u32x4){ov[0], ov[1], ov[2], ov[3]}, o1 = (u32x4){ov[4], ov[5], ov[6], ov[7]};
            const bf16x8 E0 = __builtin_bit_cast(bf16x8, e0), E1 = __builtin_bit_cast(bf16x8, e1), O0 = __builtin_bit_cast(bf16x8, o0), O1 = __builtin_bit_cast(bf16x8, o1);
#pragma unroll
            for (int ct = 0; ct < 4; ++ct) { const int cc = 16 * ct + fr;
                const bf16x8 Bc0 = *(const LAS bf16x8*)(Ct + cc * 72 + 8 * fq), Bc1 = *(const LAS bf16x8*)(Ct + cc * 72 + 32 + 8 * fq);
                const bf16x8 Bs0 = *(const LAS bf16x8*)(St + cc * 72 + 8 * fq), Bs1 = *(const LAS bf16x8*)(St + cc * 72 + 32 + 8 * fq);
                f32x4 aC = (f32x4){0.f, 0.f, 0.f, 0.f}, aS = (f32x4){0.f, 0.f, 0.f, 0.f};
                aC = __builtin_amdgcn_mfma_f32_16x16x32_bf16(E0, Bc0, aC, 0, 0, 0); aC = __builtin_amdgcn_mfma_f32_16x16x32_bf16(E1, Bc1, aC, 0, 0, 0);
                aS = __builtin_amdgcn_mfma_f32_16x16x32_bf16(O0, Bs0, aS, 0, 0, 0); aS = __builtin_amdgcn_mfma_f32_16x16x32_bf16(O1, Bs1, aS, 0, 0, 0);
                const int rho = 128 * (cc >> 5) + 32 * gi + (cc & 31);
                bf16_t* dst = ABT + ((size_t)b * 256 + rho) * 2048 + n0 + 4 * fq;
                u32x2 wc_, ws_; wc_.x = cvt_pk_bf16(aC[0], aC[1]); wc_.y = cvt_pk_bf16(aC[2], aC[3]); ws_.x = cvt_pk_bf16(aS[0], aS[1]); ws_.y = cvt_pk_bf16(aS[2], aS[3]);
                *(u32x2*)dst = wc_; *(u32x2*)(dst + 1024) = ws_; }
            if (n0 == 0) {
                const bf16_t* xh = PROJ + (tokb + 1024) * INW + C_XC + 64 * gi + 8 * fq;
                const bf16x8 H0 = *(const bf16x8*)xh, H1 = *(const bf16x8*)(xh + 32);
#pragma unroll
                for (int ct = 0; ct < 4; ++ct) { const int cc = 16 * ct + fr;
                    const bf16x8 Bc0 = *(const LAS bf16x8*)(Ct + cc * 72 + 8 * fq), Bc1 = *(const LAS bf16x8*)(Ct + cc * 72 + 32 + 8 * fq);
                    f32x4 aH = (f32x4){0.f, 0.f, 0.f, 0.f};
                    aH = __builtin_amdgcn_mfma_f32_16x16x32_bf16(H0, Bc0, aH, 0, 0, 0); aH = __builtin_amdgcn_mfma_f32_16x16x32_bf16(H1, Bc1, aH, 0, 0, 0);
                    if (fq == 0) AH[b * 256 + 128 * (cc >> 5) + 32 * gi + (cc & 31)] = aH[0]; }
            }
        }
    }
    __syncthreads();
}

#define XB_TMO      128
#define XB_XCNT(j)  (256  + 64 * (j))
#define XB_XSUB(j)  (1280 + 64 * (j))
#define XB_XGEN(j)  (2304 + 64 * (j))
#define XB_TOP      3328
#define XB_TOPGEN   3392
#define XCD_BAR_WORDS 3456
#define XB_SPIN_CAP (1u << 18)
__device__ __forceinline__ unsigned xb_ld(unsigned* p)              { return __hip_atomic_load(p, __ATOMIC_RELAXED, __HIP_MEMORY_SCOPE_AGENT); }
__device__ __forceinline__ unsigned xb_add(unsigned* p, unsigned v) { return __hip_atomic_fetch_add(p, v, __ATOMIC_RELAXED, __HIP_MEMORY_SCOPE_AGENT); }
__device__ __forceinline__ unsigned xb_xcc_id() { return (unsigned)__builtin_amdgcn_s_getreg((3 << 11) | 20) & 0xFu; }
#define XB_SPIN(cond, bar) do { unsigned _sp = 0; while (cond) { __builtin_amdgcn_s_sleep(1); \
    if ((++_sp & 255u) == 0u) { if (xb_ld(&(bar)[XB_TMO])) break; if (_sp > XB_SPIN_CAP) { atomicAdd(&(bar)[XB_TMO], 1u); break; } } } } while (0)
struct XcdBarrier { unsigned* bar; unsigned x; volatile LAS unsigned* st; };
__device__ __forceinline__ XcdBarrier xcd_barrier_post(unsigned* bar, volatile LAS unsigned* st) {
    XcdBarrier b; b.bar = bar; b.x = xb_xcc_id(); b.st = st;
    if (threadIdx.x == 0) (void)xb_add(&bar[XB_XCNT(b.x)], 1u);
    return b;
}
__device__ __forceinline__ void xcd_barrier_complete(unsigned* bar, unsigned x, unsigned& nloc, unsigned& nx) {
    const unsigned G = gridDim.x * gridDim.y * gridDim.z;
    unsigned sum, cnt, mine, sp = 0u;
    for (;;) {
        sum = 0u; cnt = 0u; mine = 0u;
#pragma unroll
        for (unsigned j = 0; j < 16; ++j) { const unsigned c = xb_ld(&bar[XB_XCNT(j)]); sum += c; cnt += (c > 0u) ? 1u : 0u; mine = (j == x) ? c : mine; }
        if (sum == G) break;
        __builtin_amdgcn_s_sleep(1);
        if ((++sp & 255u) == 0u) { if (xb_ld(&bar[XB_TMO])) break; if (sp > XB_SPIN_CAP) { atomicAdd(&bar[XB_TMO], 1u); break; } }
    }
    nloc = mine > 0u ? mine : 1u; nx = cnt > 0u ? cnt : 1u;
}
__device__ __forceinline__ void xcd_barrier(const XcdBarrier& b) {
    asm volatile("s_waitcnt vmcnt(0)" ::: "memory");
    __syncthreads();
    if (threadIdx.x == 0) {
        unsigned* bar = b.bar;
        __builtin_amdgcn_s_waitcnt(0);
        unsigned nloc = b.st[0], nx = b.st[1];
        if (nloc == 0u) { xcd_barrier_complete(bar, b.x, nloc, nx); b.st[0] = nloc; b.st[1] = nx; }
        const unsigned old = xb_add(&bar[XB_XSUB(b.x)], 1u);
        const unsigned gen = old / nloc;
        if (old + 1u == (gen + 1u) * nloc) {
            __builtin_amdgcn_fence(__ATOMIC_RELEASE, "agent");
            asm volatile("s_waitcnt vmcnt(0)" ::: "memory");
            const unsigned og = xb_add(&bar[XB_TOP], 1u);
            const unsigned tg = og / nx;
            if (og + 1u == (tg + 1u) * nx) xb_add(&bar[XB_TOPGEN], 1u);
            else XB_SPIN(xb_ld(&bar[XB_TOPGEN]) == tg, bar);
            __builtin_amdgcn_fence(__ATOMIC_ACQUIRE, "agent");
            xb_add(&bar[XB_XGEN(b.x)], 1u);
            asm volatile("s_waitcnt vmcnt(0)" ::: "memory");
        } else {
            XB_SPIN(xb_ld(&bar[XB_XGEN(b.x)]) == gen, bar);
            __builtin_amdgcn_fence(__ATOMIC_ACQUIRE, "agent");
            asm volatile("s_waitcnt vmcnt(0)" ::: "memory");
        }
    }
    __syncthreads();
}
#define GRID_SYNC() xcd_barrier(xbar)

template <int l>
__device__ __forceinline__ void layer_body(const Args& a, LAS unsigned char* lds, const XcdBarrier& xbar) {
    int t_ = threadIdx.x; asm volatile("" : "+v"(t_));
    const int tid = t_, lane = tid & 63, wid = __builtin_amdgcn_readfirstlane(tid >> 6);
    const int G = gridDim.x, bx = blockIdx.x;
    const int gw = bx * 8 + wid, ngw = G * 8;
    unsigned char* ws = a.ws;
    const float* x_in = a.in[0];
    float* out = a.out;
    bf16_t* WIN = (bf16_t*)(ws + WS_WIN); bf16_t* WOUT = (bf16_t*)(ws + WS_WOUT); bf16_t* WGU = (bf16_t*)(ws + WS_WGU); bf16_t* WDN = (bf16_t*)(ws + WS_WDN);
    bf16_t* WSP = (bf16_t*)(ws + WS_WSP); bf16_t* TT = (bf16_t*)(ws + WS_T); u64* RSB = (u64*)(ws + WS_SSQ); u64* RSA = RSB + MTOK; float* AHB = (float*)(ws + WS_SSQ + 2 * MiB);
    bf16_t* XB = (bf16_t*)(ws + WS_XB); bf16_t* ABT = (bf16_t*)(ws + WS_ABT); bf16_t* PROJ = (bf16_t*)(ws + WS_PROJ); bf16_t* MIX = (bf16_t*)(ws + WS_MIX); bf16_t* HID = (bf16_t*)(ws + WS_HID);
        { pg8::Gemm g{XB, WIN + (size_t)l * INW * DM, MTOK, INW, DM}; pg8::StaticOrder S; S.init(MTOK, INW, G, bx);
          pg8::EpiProj E{PROJ, INW, RSB};
          pg8::gemm_phase<pg8::EpiProj, pg8::StaticOrder, true, true>(lds, g, S, E); }
        GRID_SYNC();
        for (int i = bx * 512 + tid; i < 2 * MTOK; i += G * 512) RSB[i] = 0ull;
        for (int it = bx; it < NBATCH * 8; it += G) attn_item(lds, PROJ, MIX, a.in[3] + (size_t)l * 8 * 465, it, tid, wid, lane);
        for (int it = bx; it < NBATCH * 16; it += G) gate_item(lds, PROJ, MIX, a.in[4] + l * 256, a.in[5] + l * 256, WSP + (size_t)l * 4 * 128 * 128, a.in[7] + l * 512, it, wid, lane);
        chan_dft(lds, PROJ, ABT, AHB, tid, gw, ngw, lane);
        GRID_SYNC();
        { pg8::Gemm g{TT, ABT, 2048, 8192, 2048}; pg8::DftOrder S; S.init(G, bx);
          pg8::EpiDft E{MIX, AHB};
          pg8::gemm_phase<pg8::EpiDft, pg8::DftOrder, true, true>(lds, g, S, E); }
        GRID_SYNC();
        { pg8::Gemm g{MIX, WOUT + (size_t)l * DM * DM, MTOK, DM, DM}; pg8::StaticOrder S; S.init(MTOK, DM, G, bx);
          pg8::EpiRes E{XB, RSA};
          pg8::gemm_phase<pg8::EpiRes, pg8::StaticOrder, true, true>(lds, g, S, E); }
        GRID_SYNC();
        { pg8::Gemm g{XB, WGU + (size_t)l * NGU * DM, MTOK, NGU, DM}; pg8::StaticOrder S; S.init(MTOK, NGU, G, bx);
          pg8::EpiGU E{HID, RSA};
          pg8::gemm_phase<pg8::EpiGU, pg8::StaticOrder, true, true>(lds, g, S, E); }
        GRID_SYNC();
        { pg8::Gemm g{HID, WDN + (size_t)l * DM * DFF, MTOK, DM, DFF}; pg8::StaticOrder S; S.init(MTOK, DM, G, bx);
          pg8::EpiRes E{XB, RSB};
          pg8::gemm_phase<pg8::EpiRes, pg8::StaticOrder, true, true>(lds, g, S, E); }
        GRID_SYNC();
}

__global__ void __launch_bounds__(512, 2) fwd_megakernel(Args a) {
    extern __shared__ __attribute__((aligned(16))) unsigned char lds_raw[];
    LAS unsigned char* lds = (LAS unsigned char*)lds_raw;
    cg::grid_group grid = cg::this_grid();
    volatile LAS unsigned* bst = (volatile LAS unsigned*)(lds + LDS_BYTES - 16);
    if (threadIdx.x == 0) { bst[0] = 0u; bst[1] = 0u; }
    __syncthreads();
    const XcdBarrier xbar = xcd_barrier_post((unsigned*)(a.ws + WS_CTL), bst);
    const int tid = threadIdx.x, lane = tid & 63, wid = __builtin_amdgcn_readfirstlane(tid >> 6);
    const int G = gridDim.x, bx = blockIdx.x;
    const int gw = bx * 8 + wid, ngw = G * 8;
    unsigned char* ws = a.ws;
    const float* x_in = a.in[0];
    float* out = a.out;
    bf16_t* WIN = (bf16_t*)(ws + WS_WIN); bf16_t* WOUT = (bf16_t*)(ws + WS_WOUT); bf16_t* WGU = (bf16_t*)(ws + WS_WGU); bf16_t* WDN = (bf16_t*)(ws + WS_WDN);
    bf16_t* WSP = (bf16_t*)(ws + WS_WSP); bf16_t* TT = (bf16_t*)(ws + WS_T); u64* RSB = (u64*)(ws + WS_SSQ); u64* RSA = RSB + MTOK; float* AHB = (float*)(ws + WS_SSQ + 2 * MiB);
    bf16_t* XB = (bf16_t*)(ws + WS_XB); bf16_t* ABT = (bf16_t*)(ws + WS_ABT); bf16_t* PROJ = (bf16_t*)(ws + WS_PROJ); bf16_t* MIX = (bf16_t*)(ws + WS_MIX); bf16_t* HID = (bf16_t*)(ws + WS_HID);

    {
        constexpr int I_IN = 16 * 36, I_OUT = 16 * 16, I_G = 16 * 44, I_D = 44 * 16, I_L = I_IN + I_OUT + 2 * I_G + I_D;
#pragma unroll 1
        for (int it = gw; it < DEPTH * I_L; it += ngw) {
            const int l = it / I_L; int r = it % I_L;
            if (r < I_IN) { const int kb = r / 36, nb = r % 36; transpose_item(a.in[2] + (size_t)l * DM * INW, DM, INW, WIN + (size_t)l * INW * DM, 64 * nb, a.in[1] + l * DM, (64 * nb < 512) ? 0.125f * 1.44269504f : 1.0f, kb, nb, lane); continue; }
            r -= I_IN;
            if (r < I_OUT) { const int kb = r / 16, nb = r % 16; transpose_item(a.in[9] + (size_t)l * DM * DM, DM, DM, WOUT + (size_t)l * DM * DM, 64 * nb, a.in[8] + l * DM, 1.0f, kb, nb, lane); continue; }
            r -= I_OUT;
            if (r < I_G) { const int kb = r / 44, nb = r % 44, n0 = 64 * nb; transpose_item(a.in[11] + (size_t)l * DM * DFF, DM, DFF, WGU + (size_t)l * NGU * DM, (n0 >> 7) * 256 + (n0 & 127), a.in[10] + l * DM, 1.0f, kb, nb, lane); continue; }
            r -= I_G;
            if (r < I_G) { const int kb = r / 44, nb = r % 44, n0 = 64 * nb; transpose_item(a.in[12] + (size_t)l * DM * DFF, DM, DFF, WGU + (size_t)l * NGU * DM, (n0 >> 7) * 256 + 128 + (n0 & 127), a.in[10] + l * DM, 1.0f, kb, nb, lane); continue; }
            r -= I_G;
            { const int kb = r / 16, nb = r % 16; transpose_item(a.in[13] + (size_t)l * DFF * DM, DFF, DM, WDN + (size_t)l * DM * DFF, 64 * nb, nullptr, 1.0f, kb, nb, lane); }
        }
        for (int i = bx * 512 + tid; i < DEPTH * 4 * 128 * 128 / 2; i += G * 512) { const float2 v = ((const float2*)a.in[6])[i]; ((unsigned*)WSP)[i] = cvt_pk_bf16(v.x, v.y); }
#pragma unroll 1
        for (int i = bx * 512 + tid; i < 2048 * 2048 / 8; i += G * 512) { const int k = i >> 8, n8 = (i & 255) * 8; const bool sn = n8 >= 1024; const int nb = n8 & 1023;
            float v[8];
#pragma unroll
            for (int e = 0; e < 8; ++e) { const float ph = (float)((k * (nb + e)) & 2047) * (1.0f / 1024.0f); v[e] = (sn ? -sinpif(ph) : cospif(ph)) * 0.022097086912f; }
            u32x4 w; w.x = cvt_pk_bf16(v[0], v[1]); w.y = cvt_pk_bf16(v[2], v[3]); w.z = cvt_pk_bf16(v[4], v[5]); w.w = cvt_pk_bf16(v[6], v[7]);
            *(u32x4*)(TT + (size_t)k * 2048 + n8) = w; }
#pragma unroll 1
        for (int m0 = gw; m0 < MTOK; m0 += 4 * ngw) { f32x4 v[4][4];
#pragma unroll
            for (int q = 0; q < 4; ++q) { const f32x4* xr = (const f32x4*)(x_in + (size_t)(m0 + q * ngw) * DM) + lane;
#pragma unroll
                for (int jj = 0; jj < 4; ++jj) v[q][jj] = xr[64 * jj]; }
#pragma unroll
            for (int q = 0; q < 4; ++q) { const int m = m0 + q * ngw; float s = 0.f; u32x2* o8 = (u32x2*)(XB + (size_t)m * DM) + lane;
#pragma unroll
                for (int jj = 0; jj < 4; ++jj) { const f32x4 t = v[q][jj]; s += (t[0] * t[0] + t[1] * t[1]) + (t[2] * t[2] + t[3] * t[3]); u32x2 w; w.x = cvt_pk_bf16(t[0], t[1]); w.y = cvt_pk_bf16(t[2], t[3]); o8[64 * jj] = w; }
                s = wave_sum(s);
                if (lane == 0) RSB[m] = (u64)(s * RSS_SCALE); } }
    }
    GRID_SYNC();

    layer_body<0>(a, lds, xbar);
    layer_body<1>(a, lds, xbar); layer_body<2>(a, lds, xbar); layer_body<3>(a, lds, xbar);
    {
        const float* fg = a.in[14];
        f32x4 gv[4];
#pragma unroll
        for (int jj = 0; jj < 4; ++jj) gv[jj] = ((const f32x4*)fg)[lane + 64 * jj];
#pragma unroll 1
        for (int m0 = gw; m0 < MTOK; m0 += 4 * ngw) { u32x2 v[4][4];
#pragma unroll
            for (int q = 0; q < 4; ++q) { const u32x2* xr = (const u32x2*)(XB + (size_t)(m0 + q * ngw) * DM) + lane;
#pragma unroll
                for (int jj = 0; jj < 4; ++jj) v[q][jj] = xr[64 * jj]; }
#pragma unroll
            for (int q = 0; q < 4; ++q) { f32x4* xr = (f32x4*)(out + (size_t)(m0 + q * ngw) * DM) + lane; float s = 0.f; f32x4 t[4];
#pragma unroll
                for (int jj = 0; jj < 4; ++jj) { t[jj] = (f32x4){bf2f(v[q][jj].x & 0xffffu), bf2f(v[q][jj].x >> 16), bf2f(v[q][jj].y & 0xffffu), bf2f(v[q][jj].y >> 16)}; s += (t[jj][0] * t[jj][0] + t[jj][1] * t[jj][1]) + (t[jj][2] * t[jj][2] + t[jj][3] * t[jj][3]); }
                const float rs = rsqrtf(wave_sum(s) * (1.0f / 1024.0f) + EPS);
#pragma unroll
                for (int jj = 0; jj < 4; ++jj) xr[64 * jj] = t[jj] * rs * gv[jj]; } }
    }
    grid.sync();
}

extern "C" void kernel_launch(void* const* d_in, const int* in_sizes, int n_in, void* d_out, int out_size, void* d_ws, size_t ws_size, hipStream_t stream) {
    static int grid = 0;
    if (grid == 0) {
        if (n_in != 15 || in_sizes[0] != MTOK * DM || out_size != MTOK * DM || ws_size < WS_END) { fprintf(stderr, "kernel_launch: unexpected shapes (n_in %d, in0 %d, out %d, ws %zu)\n", n_in, n_in > 0 ? in_sizes[0] : -1, out_size, ws_size); grid = -1; return; }
        int dev = 0, cus = 0, per_cu = 0;
        hipGetDevice(&dev);
        hipDeviceGetAttribute(&cus, hipDeviceAttributeMultiprocessorCount, dev);
        if (hipFuncSetAttribute((const void*)fwd_megakernel, hipFuncAttributeMaxDynamicSharedMemorySize, LDS_BYTES) != hipSuccess) { fprintf(stderr, "kernel_launch: hipFuncSetAttribute(%d B dynamic LDS) failed\n", LDS_BYTES); grid = -1; return; }
        if (hipOccupancyMaxActiveBlocksPerMultiprocessor(&per_cu, (const void*)fwd_megakernel, 512, LDS_BYTES) != hipSuccess || per_cu < 1) { fprintf(stderr, "kernel_launch: occupancy query says %d blocks per CU\n", per_cu); (void)hipGetLastError(); per_cu = 1; }
        grid = cus * per_cu;
        fprintf(stderr, "kernel_launch: grid %d (cus %d x %d)\n", grid, cus, per_cu);
    }
    if (grid < 0) return;
    if (hipMemsetAsync((char*)d_ws + WS_CTL, 0, 16384, stream) != hipSuccess) { fprintf(stderr, "kernel_launch: memset of the barrier word failed\n"); return; }
    Args a{};
    for (int i = 0; i < 15; ++i) a.in[i] = (const float*)d_in[i];
    a.out = (float*)d_out; a.ws = (unsigned char*)d_ws;
    void* args[] = {&a};
    hipError_t e = hipLaunchCooperativeKernel((const void*)fwd_megakernel, dim3(grid), dim3(512), args, LDS_BYTES, stream);
    if (e != hipSuccess) fprintf(stderr, "cooperative launch failed: %s (grid %d)\n", hipGetErrorString(e), grid);
}
```
